# Optimizing an MI355X kernel written in HIP

```python
import math
import jax
import jax.numpy as jnp
from jax import lax
import numpy as np

D_MODEL = 2048
BATCH = 32
SEQ = 256
DEPTH = 4
DEC_BATCH = 2
DEC_SEQ = 4096
PAST_LEN = 512

GRID_W = 64
N_EVEN = (DEPTH + 1) // 2
N_ODD = DEPTH // 2
N_MOD = 9
D_FF = 5632
EPS = 1e-6
MIX_HALF = D_MODEL // 2

S5_WIDTH = MIX_HALF
S5_H = 16
S5_GROUPS = S5_WIDTH // S5_H
S5_P = 64
S5_LAM_RE_MAX = -1e-4
HY_WIDTH = MIX_HALF
HY_ORDER = 2
HY_SHORT = 3
HY_BANDS = 16
HY_EMB = 1 + 2 * HY_BANDS
HY_FFN = 64
HY_DECAY_MIN = -math.log(1e-2) / 1.5
HY_DECAY_MAX = -math.log(1e-2) / 0.3
RG_WIDTH = MIX_HALF
RG_BLOCKS = 16
RG_BW = RG_WIDTH // RG_BLOCKS
RG_CONV = 4
RG_C = 8.0
NA_HD = 64
NA_HEADS = MIX_HALF // NA_HD
NA_WIDTH = NA_HEADS * NA_HD
NA_WIN_R = 8
NA_WIN_C = 16
Q_BLOCK = 128

EVEN_IN = S5_WIDTH + 3 * HY_WIDTH
EVEN_OUT = S5_WIDTH + HY_WIDTH
ODD_IN = 2 * RG_WIDTH + 3 * NA_WIDTH
ODD_OUT = RG_WIDTH + NA_WIDTH

kernel_name = 'hybrid_diffusion_prefix_trunk_step'


def rmsnorm(x, g):
    xf = x.astype(jnp.float32)
    y = xf * lax.rsqrt(jnp.mean(xf * xf, axis=-1, keepdims=True) + EPS)
    return (y * g.astype(jnp.float32)).astype(x.dtype)


def modulate(x, g, shift, scale):
    return rmsnorm(x, g) * (1 + scale) + shift


def swiglu(h, wg, wu, wd):
    return (jax.nn.silu(h @ wg) * (h @ wu)) @ wd


def adaln(cond, w, b):
    m = jax.nn.silu(cond) @ w + b
    return jnp.split(m[:, None, :], N_MOD, axis=-1)


def pre_mix(x, m, g, wg, wu, wd):
    x = x + 0.5 * m[2] * swiglu(modulate(x, g[0], m[0], m[1]), wg[0], wu[0], wd[0])
    return x, modulate(x, g[1], m[3], m[4])


def post_mix(x, y, m, g, wg, wu, wd):
    x = x + m[5] * y
    return x + 0.5 * m[8] * swiglu(modulate(x, g[2], m[6], m[7]), wg[1], wu[1], wd[1])


def depthwise_conv(x, w, b, left):
    K = w.shape[0]
    L = x.shape[1]
    xp = jnp.pad(x, ((0, 0), (left, K - 1 - left), (0, 0)))
    y = b + xp[:, 0:L] * w[0]
    for j in range(1, K):
        y = y + xp[:, j:j + L] * w[j]
    return y


def _cmul(ar, ai, br, bi):
    return ar * br - ai * bi, ar * bi + ai * br


def _complex_combine(e1, e2):
    a1r, a1i, b1r, b1i = e1
    a2r, a2i, b2r, b2i = e2
    ar, ai = _cmul(a2r, a2i, a1r, a1i)
    br, bi = _cmul(a2r, a2i, b1r, b1i)
    return ar, ai, br + b2r, bi + b2i


def _real_combine(e1, e2):
    a1, b1 = e1
    a2, b2 = e2
    return a1 * a2, a2 * b1 + b2


def complex_scan(ar, ai, br, bi, h0r, h0i):
    ir, ii = _cmul(ar, ai, h0r, h0i)
    br = br.at[:, 0].add(ir)
    bi = bi.at[:, 0].add(ii)
    elems = (jnp.broadcast_to(ar, br.shape), jnp.broadcast_to(ai, bi.shape), br, bi)
    _, _, hr, hi = lax.associative_scan(_complex_combine, elems, axis=1)
    return hr, hi


def real_scan(a, b, h0):
    b = b.at[:, 0].add(a[:, 0] * h0)
    _, h = lax.associative_scan(_real_combine, (a, b), axis=1)
    return h


def s5_mixer(u, lam_re, lam_im, log_dt, b_re, b_im, c_re, c_im, d_skip, glu_w, glu_b, h0, want_state):
    f32 = jnp.float32
    bsz, L, _ = u.shape
    uf = u.astype(f32).reshape(bsz, L, S5_GROUPS, S5_H)
    h0 = h0.astype(f32)
    y = d_skip.astype(f32) * uf
    finals = []
    for d in range(2):
        lr = jnp.minimum(lam_re[d].astype(f32), S5_LAM_RE_MAX)
        li = lam_im[d].astype(f32)
        dt = jnp.exp(log_dt[d].astype(f32))[:, None]
        mag = jnp.exp(lr * dt)
        abr, abi = mag * jnp.cos(li * dt), mag * jnp.sin(li * dt)
        den = lr * lr + li * li
        cr = ((abr - 1.0) * lr + abi * li) / den
        ci = (abi * lr - (abr - 1.0) * li) / den
        br_, bi_ = b_re[d].astype(f32), b_im[d].astype(f32)
        bbr = cr[..., None] * br_ - ci[..., None] * bi_
        bbi = cr[..., None] * bi_ + ci[..., None] * br_
        ud = uf if d == 0 else uf[:, ::-1]
        bur = jnp.einsum('gph,blgh->blgp', bbr, ud)
        bui = jnp.einsum('gph,blgh->blgp', bbi, ud)
        hr, hi = complex_scan(abr, abi, bur, bui, h0[:, d, ..., 0], h0[:, d, ..., 1])
        if want_state:
            finals.append(jnp.stack([hr[:, -1], hi[:, -1]], axis=-1))
        if d == 1:
            hr, hi = hr[:, ::-1], hi[:, ::-1]
        y = y + jnp.einsum('ghp,blgp->blgh', c_re[d].astype(f32), hr) - jnp.einsum('ghp,blgp->blgh', c_im[d].astype(f32), hi)
    z = jax.nn.gelu(y.reshape(bsz, L, S5_WIDTH))
    out = z * jax.nn.sigmoid(z @ glu_w.astype(f32) + glu_b.astype(f32))
    fin = jnp.stack(finals, axis=1) if want_state else None
    return out.astype(u.dtype), fin


def hyena_filters(L, w1, b1, w2, b2, w3, freq, decay):
    f32 = jnp.float32
    t = jnp.arange(L, dtype=f32)
    t01 = t / L
    bands = jnp.linspace(1e-4, HY_BANDS - 1, HY_BANDS, dtype=f32)
    ang = (2.0 * math.pi / L) * t[:, None] * bands[None, :]
    z = jnp.concatenate([t01[:, None], jnp.cos(ang), -jnp.sin(ang)], axis=-1)
    fr = freq.astype(f32)
    h = jnp.sin(fr * (z @ w1.astype(f32) + b1.astype(f32)))
    h = jnp.sin(fr * (h @ w2.astype(f32) + b2.astype(f32)))
    h = (h @ w3.astype(f32)).reshape(L, HY_ORDER, 2, HY_WIDTH)
    h = h * jnp.exp(-t01[:, None, None, None] * jnp.abs(decay.astype(f32)))
    k = jnp.concatenate([h[:, :, 0], jnp.zeros((1, HY_ORDER, HY_WIDTH), f32), h[:0:-1, :, 1]], axis=0)
    return k / jnp.sum(jnp.abs(k), axis=0, keepdims=True)


def hyena_mixer(p, conv_w, conv_b, w1, b1, w2, b2, w3, freq, decay, bias):
    f32 = jnp.float32
    bsz, L, _ = p.shape
    u = depthwise_conv(p, conv_w, conv_b, HY_SHORT // 2).astype(f32)
    v, g1, g2 = u[..., :HY_WIDTH], u[..., HY_WIDTH:2 * HY_WIDTH], u[..., 2 * HY_WIDTH:]
    kf = jnp.fft.rfft(hyena_filters(L, w1, b1, w2, b2, w3, freq, decay), axis=0)
    z = v
    for n, gate in enumerate((g1, g2)):
        zf = jnp.fft.rfft(z, n=2 * L, axis=1)
        conv = jnp.fft.irfft(zf * kf[:, n], n=2 * L, axis=1)[:, :L]
        z = gate * (conv + bias[n].astype(f32) * z)
    return z.astype(p.dtype)


def rglru_mixer(xb, gb, conv_w, conv_b, w_a, b_a, w_i, b_i, lam, h0, want_state):
    f32 = jnp.float32
    bsz, L, _ = xb.shape
    xc = depthwise_conv(xb, conv_w, conv_b, RG_CONV // 2).astype(f32)
    h0 = h0.astype(f32)
    hsum = jnp.zeros_like(xc)
    finals = []
    for d in range(2):
        xd = xc if d == 0 else xc[:, ::-1]
        xs = xd.reshape(bsz, L, RG_BLOCKS, RG_BW)
        r = jax.nn.sigmoid(jnp.einsum('blnc,ncd->blnd', xs, w_a[d].astype(f32)) + b_a[d].astype(f32)).reshape(bsz, L, RG_WIDTH)
        i = jax.nn.sigmoid(jnp.einsum('blnc,ncd->blnd', xs, w_i[d].astype(f32)) + b_i[d].astype(f32)).reshape(bsz, L, RG_WIDTH)
        log_a = -RG_C * r * jax.nn.softplus(-lam[d].astype(f32))
        a = jnp.exp(log_a)
        b = jnp.sqrt(-jnp.expm1(2.0 * log_a)) * (i * xd)
        h = real_scan(a, b, h0[:, d])
        if want_state:
            finals.append(h[:, -1])
        if d == 1:
            h = h[:, ::-1]
        hsum = hsum + h
    y = hsum * jax.nn.gelu(gb.astype(f32))
    fin = jnp.stack(finals, axis=1) if want_state else None
    return y.astype(xb.dtype), fin


def ctx_attention(q, k, v):
    bsz, Lc, H, hd = q.shape
    scale = hd ** -0.5
    qb = jnp.moveaxis(q.reshape(bsz, Lc // Q_BLOCK, Q_BLOCK, H, hd), 1, 0)

    def block(qi):
        s = jnp.einsum('bqhd,bkhd->bhqk', qi, k).astype(jnp.float32) * scale
        p = jax.nn.softmax(s, axis=-1).astype(v.dtype)
        return jnp.einsum('bhqk,bkhd->bqhd', p, v)

    o = lax.map(block, qb)
    return jnp.moveaxis(o, 0, 1).reshape(bsz, Lc, H * hd)


def na_attention(q, k, v, k_ctx, v_ctx, rpb):
    bsz, L, H, hd = q.shape
    rows = L // GRID_W
    wr = min(NA_WIN_R, rows)
    wc = NA_WIN_C
    scale = hd ** -0.5
    qg = q.reshape(bsz, rows, GRID_W, H, hd)
    kg = k.reshape(bsz, rows, GRID_W, H, hd)
    vg = v.reshape(bsz, rows, GRID_W, H, hd)
    col = jnp.arange(GRID_W)
    col_idx = jnp.clip(col - wc // 2, 0, GRID_W - wc)[:, None] + jnp.arange(wc)[None, :]
    col_bias = rpb[:, :, col_idx - col[:, None] + NA_WIN_C - 1]

    def row_block(r):
        rs = jnp.clip(r - wr // 2, 0, rows - wr)
        kr = lax.dynamic_slice_in_dim(kg, rs, wr, axis=1)[:, :, col_idx]
        vr = lax.dynamic_slice_in_dim(vg, rs, wr, axis=1)[:, :, col_idx]
        qr = lax.dynamic_index_in_dim(qg, r, axis=1, keepdims=False)
        bias = col_bias[:, rs + jnp.arange(wr) - r + NA_WIN_R - 1]
        s_loc = jnp.einsum('bqhd,brqchd->bhqrc', qr, kr).astype(jnp.float32) * scale
        s_loc = s_loc + jnp.transpose(bias, (0, 2, 1, 3)).astype(jnp.float32)[None]
        s_ctx = jnp.einsum('bqhd,bkhd->bhqk', qr, k_ctx).astype(jnp.float32) * scale
        s = jnp.concatenate([s_loc.reshape(bsz, H, GRID_W, wr * wc), s_ctx], axis=-1)
        p = jax.nn.softmax(s, axis=-1).astype(v.dtype)
        p_loc = p[..., :wr * wc].reshape(bsz, H, GRID_W, wr, wc)
        return (jnp.einsum('bhqrc,brqchd->bqhd', p_loc, vr)
                + jnp.einsum('bhqk,bkhd->bqhd', p[..., wr * wc:], v_ctx))

    o = lax.map(row_block, jnp.arange(rows))
    return jnp.moveaxis(o, 0, 1).reshape(bsz, L, H * hd)


def setup_inputs(seed: int = 0) -> dict:
    key = jax.random.key(seed)
    ks = iter(jax.random.split(key, 80))
    f32 = jnp.float32

    def nrm(shape, s):
        return s * jax.random.normal(next(ks), shape, f32)

    x_prompt = nrm((BATCH, SEQ, D_MODEL), 1.0)
    x_sample = nrm((DEC_BATCH, DEC_SEQ, D_MODEL), 1.0)
    cache_na_k = nrm((DEC_BATCH, N_ODD, PAST_LEN, NA_HEADS, NA_HD), 1.0)
    cache_na_v = nrm((DEC_BATCH, N_ODD, PAST_LEN, NA_HEADS, NA_HD), 1.0)
    state_s5 = nrm((DEC_BATCH, N_EVEN, 2, S5_GROUPS, S5_P, 2), 0.1)
    state_rglru = nrm((DEC_BATCH, N_ODD, 2, RG_WIDTH), 0.5)
    c = nrm((DEC_BATCH, D_MODEL), 1.0)
    c_ctx = nrm((D_MODEL,), 1.0)
    norm_g = 1.0 + nrm((DEPTH, 3, D_MODEL), 0.1)
    mod_w = nrm((DEPTH, D_MODEL, N_MOD * D_MODEL), 0.5 * D_MODEL ** -0.5)
    mod_b = nrm((DEPTH, N_MOD * D_MODEL), 0.01)
    ffn_wg = nrm((DEPTH, 2, D_MODEL, D_FF), D_MODEL ** -0.5)
    ffn_wu = nrm((DEPTH, 2, D_MODEL, D_FF), D_MODEL ** -0.5)
    ffn_wd = nrm((DEPTH, 2, D_FF, D_MODEL), D_FF ** -0.5)
    even_w_in = nrm((N_EVEN, D_MODEL, EVEN_IN), D_MODEL ** -0.5)
    even_w_out = nrm((N_EVEN, EVEN_OUT, D_MODEL), EVEN_OUT ** -0.5)
    s5_lam_re = -0.5 + nrm((N_EVEN, 2, S5_GROUPS, S5_P), 0.01)
    s5_lam_im = math.pi * jnp.arange(S5_P, dtype=f32) + nrm((N_EVEN, 2, S5_GROUPS, S5_P), 0.01)
    s5_log_dt = jax.random.uniform(next(ks), (N_EVEN, 2, S5_GROUPS), f32, math.log(1e-3), math.log(1e-1))
    s5_b_re = nrm((N_EVEN, 2, S5_GROUPS, S5_P, S5_H), (2 * S5_H) ** -0.5)
    s5_b_im = nrm((N_EVEN, 2, S5_GROUPS, S5_P, S5_H), (2 * S5_H) ** -0.5)
    s5_c_re = nrm((N_EVEN, 2, S5_GROUPS, S5_H, S5_P), S5_P ** -0.5)
    s5_c_im = nrm((N_EVEN, 2, S5_GROUPS, S5_H, S5_P), S5_P ** -0.5)
    s5_d = nrm((N_EVEN, S5_GROUPS, S5_H), 1.0)
    s5_glu_w = nrm((N_EVEN, S5_WIDTH, S5_WIDTH), S5_WIDTH ** -0.5)
    s5_glu_b = nrm((N_EVEN, S5_WIDTH), 0.01)
    hy_conv_w = nrm((N_EVEN, HY_SHORT, 3 * HY_WIDTH), HY_SHORT ** -0.5)
    hy_conv_b = nrm((N_EVEN, 3 * HY_WIDTH), 0.01)
    hy_w1 = nrm((N_EVEN, HY_EMB, HY_FFN), HY_EMB ** -0.5)
    hy_b1 = nrm((N_EVEN, HY_FFN), 0.1)
    hy_w2 = nrm((N_EVEN, HY_FFN, HY_FFN), HY_FFN ** -0.5)
    hy_b2 = nrm((N_EVEN, HY_FFN), 0.1)
    hy_w3 = nrm((N_EVEN, HY_FFN, HY_ORDER * 2 * HY_WIDTH), HY_FFN ** -0.5)
    hy_freq = 1.0 + nrm((N_EVEN, HY_FFN), 0.1)
    hy_decay = jnp.linspace(HY_DECAY_MIN, HY_DECAY_MAX, HY_WIDTH, dtype=f32) + nrm((N_EVEN, HY_ORDER, 2, HY_WIDTH), 0.1)
    hy_bias = nrm((N_EVEN, HY_ORDER, HY_WIDTH), 1.0)
    odd_w_in = nrm((N_ODD, D_MODEL, ODD_IN), D_MODEL ** -0.5)
    odd_w_out = nrm((N_ODD, ODD_OUT, D_MODEL), ODD_OUT ** -0.5)
    rg_conv_w = nrm((N_ODD, RG_CONV, RG_WIDTH), RG_CONV ** -0.5)
    rg_conv_b = nrm((N_ODD, RG_WIDTH), 0.01)
    rg_wa = nrm((N_ODD, 2, RG_BLOCKS, RG_BW, RG_BW), RG_BW ** -0.5)
    rg_ba = nrm((N_ODD, 2, RG_BLOCKS, RG_BW), 0.1)
    rg_wi = nrm((N_ODD, 2, RG_BLOCKS, RG_BW, RG_BW), RG_BW ** -0.5)
    rg_bi = nrm((N_ODD, 2, RG_BLOCKS, RG_BW), 0.1)
    a_c = jax.random.uniform(next(ks), (N_ODD, 2, RG_WIDTH), f32, 0.9, 0.999)
    s_a = a_c ** (1.0 / RG_C)
    rg_lam = jnp.log(s_a) - jnp.log1p(-s_a)
    na_qn = 1.0 + nrm((N_ODD, NA_HD), 0.1)
    na_kn = 1.0 + nrm((N_ODD, NA_HD), 0.1)
    na_rpb = nrm((N_ODD, NA_HEADS, 2 * NA_WIN_R - 1, 2 * NA_WIN_C - 1), 0.1)
    return {'x_prompt': x_prompt, 'x_sample': x_sample, 'cache_na_k': cache_na_k, 'cache_na_v': cache_na_v,
            'state_s5': state_s5, 'state_rglru': state_rglru, 'c': c, 'c_ctx': c_ctx,
            'norm_g': norm_g, 'mod_w': mod_w, 'mod_b': mod_b, 'ffn_wg': ffn_wg, 'ffn_wu': ffn_wu, 'ffn_wd': ffn_wd,
            'even_w_in': even_w_in, 'even_w_out': even_w_out,
            's5_lam_re': s5_lam_re, 's5_lam_im': s5_lam_im, 's5_log_dt': s5_log_dt, 's5_b_re': s5_b_re, 's5_b_im': s5_b_im,
            's5_c_re': s5_c_re, 's5_c_im': s5_c_im, 's5_d': s5_d, 's5_glu_w': s5_glu_w, 's5_glu_b': s5_glu_b,
            'hy_conv_w': hy_conv_w, 'hy_conv_b': hy_conv_b, 'hy_w1': hy_w1, 'hy_b1': hy_b1, 'hy_w2': hy_w2, 'hy_b2': hy_b2,
            'hy_w3': hy_w3, 'hy_freq': hy_freq, 'hy_decay': hy_decay, 'hy_bias': hy_bias,
            'odd_w_in': odd_w_in, 'odd_w_out': odd_w_out, 'rg_conv_w': rg_conv_w, 'rg_conv_b': rg_conv_b,
            'rg_wa': rg_wa, 'rg_ba': rg_ba, 'rg_wi': rg_wi, 'rg_bi': rg_bi, 'rg_lam': rg_lam,
            'na_qn': na_qn, 'na_kn': na_kn, 'na_rpb': na_rpb}


def reference(x_prompt, x_sample, cache_na_k, cache_na_v, state_s5, state_rglru, c, c_ctx,
              norm_g, mod_w, mod_b, ffn_wg, ffn_wu, ffn_wd, even_w_in, even_w_out,
              s5_lam_re, s5_lam_im, s5_log_dt, s5_b_re, s5_b_im, s5_c_re, s5_c_im, s5_d, s5_glu_w, s5_glu_b,
              hy_conv_w, hy_conv_b, hy_w1, hy_b1, hy_w2, hy_b2, hy_w3, hy_freq, hy_decay, hy_bias,
              odd_w_in, odd_w_out, rg_conv_w, rg_conv_b, rg_wa, rg_ba, rg_wi, rg_bi, rg_lam,
              na_qn, na_kn, na_rpb):

    def even_mix(h, ei, s5_h0, want_state):
        proj = h @ even_w_in[ei]
        y_a, s5_fin = s5_mixer(proj[..., :S5_WIDTH], s5_lam_re[ei], s5_lam_im[ei], s5_log_dt[ei],
                               s5_b_re[ei], s5_b_im[ei], s5_c_re[ei], s5_c_im[ei], s5_d[ei],
                               s5_glu_w[ei], s5_glu_b[ei], s5_h0, want_state)
        y_b = hyena_mixer(proj[..., S5_WIDTH:], hy_conv_w[ei], hy_conv_b[ei], hy_w1[ei], hy_b1[ei],
                          hy_w2[ei], hy_b2[ei], hy_w3[ei], hy_freq[ei], hy_decay[ei], hy_bias[ei])
        return jnp.concatenate([y_a, y_b], axis=-1) @ even_w_out[ei], s5_fin

    def odd_mix(h, oi, rg_h0, kv_ctx):
        want_state = kv_ctx is None
        proj = h @ odd_w_in[oi]
        bsz, L, _ = proj.shape
        y_c, rg_fin = rglru_mixer(proj[..., :RG_WIDTH], proj[..., RG_WIDTH:2 * RG_WIDTH], rg_conv_w[oi],
                                  rg_conv_b[oi], rg_wa[oi], rg_ba[oi], rg_wi[oi], rg_bi[oi], rg_lam[oi],
                                  rg_h0, want_state)
        qkv = proj[..., 2 * RG_WIDTH:].reshape(bsz, L, 3, NA_HEADS, NA_HD)
        q = rmsnorm(qkv[:, :, 0], na_qn[oi])
        k = rmsnorm(qkv[:, :, 1], na_kn[oi])
        v = qkv[:, :, 2]
        if want_state:
            y_d = ctx_attention(q, k, v)
            aux = (rg_fin, k, v)
        else:
            y_d = na_attention(q, k, v, kv_ctx[0], kv_ctx[1], na_rpb[oi])
            aux = None
        return jnp.concatenate([y_c, y_d], axis=-1) @ odd_w_out[oi], aux

    x = x_prompt
    bp = x.shape[0]
    s5_new, rg_new, k_new, v_new = [], [], [], []
    for li in range(DEPTH):
        m = adaln(c_ctx[None], mod_w[li], mod_b[li])
        x, h = pre_mix(x, m, norm_g[li], ffn_wg[li], ffn_wu[li], ffn_wd[li])
        if li % 2 == 0:
            y, s5_fin = even_mix(h, li // 2, jnp.zeros((bp, 2, S5_GROUPS, S5_P, 2), jnp.float32), True)
            s5_new.append(s5_fin.astype(x_prompt.dtype))
        else:
            y, (rg_fin, k_c, v_c) = odd_mix(h, li // 2, jnp.zeros((bp, 2, RG_WIDTH), jnp.float32), None)
            rg_new.append(rg_fin.astype(x_prompt.dtype))
            k_new.append(k_c)
            v_new.append(v_c)
        x = post_mix(x, y, m, norm_g[li], ffn_wg[li], ffn_wu[li], ffn_wd[li])
    y_prompt = x

    x = x_sample
    for li in range(DEPTH):
        m = adaln(c, mod_w[li], mod_b[li])
        x, h = pre_mix(x, m, norm_g[li], ffn_wg[li], ffn_wu[li], ffn_wd[li])
        if li % 2 == 0:
            y, _ = even_mix(h, li // 2, state_s5[:, li // 2], False)
        else:
            oi = li // 2
            y, _ = odd_mix(h, oi, state_rglru[:, oi], (cache_na_k[:, oi], cache_na_v[:, oi]))
        x = post_mix(x, y, m, norm_g[li], ffn_wg[li], ffn_wu[li], ffn_wd[li])
    y_sample = x

    new_na_k = jnp.stack(k_new, axis=1)
    new_na_v = jnp.stack(v_new, axis=1)
    new_s5 = jnp.stack(s5_new, axis=1)
    new_rglru = jnp.stack(rg_new, axis=1)
    return (y_prompt, y_sample, new_na_k, new_na_v, new_s5, new_rglru)
```

```cpp
#include <hip/hip_runtime.h>
#include <cstdio>
#include <cstdint>
namespace pg8 {
#define PG8_LAS __attribute__((address_space(3)))
typedef unsigned short bf16_t;
typedef short bf16x8 __attribute__((ext_vector_type(8)));
typedef float f32x4 __attribute__((ext_vector_type(4)));
typedef unsigned u32x4 __attribute__((ext_vector_type(4)));
constexpr int BM = 256, BK = 64, HALF = 128, HTB = HALF * BK * 2  , STAGE_BYTES = 8 * HTB, NXCD = 8, WGM = 8;

__host__ __device__ __forceinline__ int lds_byte(int r, int c) { const int st = (r >> 4) * 2 + (c >> 5), rr = r & 15, cc = c & 31, ob = rr * 64 + cc * 2; return st * 1024 + (ob ^ (((ob >> 9) & 1) << 5)); }
__host__ __device__ __forceinline__ void stage_rc(int b, int& R, int& C) { const int st = b / 1024, sb = b % 1024, swz = sb ^ (((sb >> 9) & 1) << 5); R = (st >> 1) * 16 + swz / 64; C = (st & 1) * 32 + (swz % 64) / 2; }
__host__ __device__ __forceinline__ int perm32(int rho) { const int n = rho >> 4, i = rho & 15; return 8 * (i >> 2) + 4 * n + (i & 3); }

struct Unit { int pm, pn; };
struct Gemm { const bf16_t* A; const bf16_t* Bt; int M, N, K; };

struct StaticOrder {
    int nM, nN, nwg, G, c;
    __host__ __device__ void init(int M, int N, int G_, int c_) { nM = M / BM; nN = N / BM; nwg = nM * nN; G = G_; c = c_; }
    __host__ __device__ bool next(int i, Unit& u) const {
        const long L = (long)i * G + c; if (L >= nwg) return false;
        int wgid = (int)L; { const int q = nwg / NXCD, r = nwg % NXCD, xcd = wgid % NXCD, off = wgid / NXCD; wgid = (xcd < r ? xcd * (q + 1) : r * (q + 1) + (xcd - r) * q) + off; }
        const int nig = WGM * nN, gid = wgid / nig, fm = gid * WGM, gsz = (nM - fm) < WGM ? (nM - fm) : WGM;
        u.pm = fm + ((wgid % nig) % gsz); u.pn = (wgid % nig) / gsz; return true;
    }
    __device__ __forceinline__ void a_ready(const Unit&) const {}
    __device__ __forceinline__ void done(const Unit&) const {}
};

__device__ __forceinline__ unsigned cvt_pk_bf16(float lo, float hi) { unsigned r; asm volatile("v_cvt_pk_bf16_f32 %0, %1, %2" : "=v"(r) : "v"(lo), "v"(hi)); return r; }
__device__ __forceinline__ float fsigmoid(float x) { return __builtin_amdgcn_rcpf(1.0f + __expf(-x)); }

struct EpiF32 {
    static constexpr bool PERM = false, AFTER_DRAIN = false;
    float* C; int ldc;
    __device__ __forceinline__ void operator()(const f32x4 (&acc)[2][2][4][2], const Unit& u, int wr, int wc, int fr, int fq) const {
        const int row0 = u.pm * BM + wr * 64 + fr, col0 = u.pn * BM + wc * 32 + 4 * fq;
#pragma unroll
        for (int ai = 0; ai < 2; ++ai)
#pragma unroll
            for (int m = 0; m < 4; ++m) { float* rowp = C + (size_t)(row0 + ai * HALF + m * 16) * ldc + col0;
#pragma unroll
                for (int bj = 0; bj < 2; ++bj)
#pragma unroll
                    for (int n = 0; n < 2; ++n) *(f32x4*)(rowp + bj * HALF + n * 16) = acc[ai][bj][m][n]; }
    }
};
struct EpiBf16 {
    static constexpr bool PERM = true, AFTER_DRAIN = false;
    bf16_t* O; int ldc;
    __device__ __forceinline__ void operator()(const f32x4 (&acc)[2][2][4][2], const Unit& u, int wr, int wc, int fr, int fq) const {
        const int row0 = u.pm * BM + wr * 64 + fr, col0 = u.pn * BM + wc * 32 + 8 * fq;
#pragma unroll
        for (int ai = 0; ai < 2; ++ai)
#pragma unroll
            for (int m = 0; m < 4; ++m) { bf16_t* rowp = O + (size_t)(row0 + ai * HALF + m * 16) * ldc + col0;
#pragma unroll
                for (int bj = 0; bj < 2; ++bj) { const f32x4 v0 = acc[ai][bj][m][0], v1 = acc[ai][bj][m][1];
                    u32x4 w; w.x = cvt_pk_bf16(v0[0], v0[1]); w.y = cvt_pk_bf16(v0[2], v0[3]); w.z = cvt_pk_bf16(v1[0], v1[1]); w.w = cvt_pk_bf16(v1[2], v1[3]);
                    *(u32x4*)(rowp + bj * HALF) = w; } }
    }
};
struct EpiSwiGLU {
    static constexpr bool PERM = true, AFTER_DRAIN = false;
    bf16_t* O; int ldc;
    __device__ __forceinline__ void operator()(const f32x4 (&acc)[2][2][4][2], const Unit& u, int wr, int wc, int fr, int fq) const {
        const int row0 = u.pm * BM + wr * 64 + fr, col0 = u.pn * HALF + wc * 32 + 8 * fq;
#pragma unroll
        for (int ai = 0; ai < 2; ++ai)
#pragma unroll
            for (int m = 0; m < 4; ++m) { bf16_t* rowp = O + (size_t)(row0 + ai * HALF + m * 16) * ldc + col0;
                f32x4 r0, r1;
#pragma unroll
                for (int j = 0; j < 4; ++j) { const float g0 = acc[ai][0][m][0][j], g1 = acc[ai][0][m][1][j];
                    r0[j] = g0 * fsigmoid(g0) * acc[ai][1][m][0][j]; r1[j] = g1 * fsigmoid(g1) * acc[ai][1][m][1][j]; }
                u32x4 w; w.x = cvt_pk_bf16(r0[0], r0[1]); w.y = cvt_pk_bf16(r0[2], r0[3]); w.z = cvt_pk_bf16(r1[0], r1[1]); w.w = cvt_pk_bf16(r1[2], r1[3]);
                *(u32x4*)rowp = w; }
    }
};
struct EpiResid {
    static constexpr bool PERM = false, AFTER_DRAIN = false;
    float* X; int ldc; const float* gate; int gstride; float coef;
    __device__ __forceinline__ void operator()(const f32x4 (&acc)[2][2][4][2], const Unit& u, int wr, int wc, int fr, int fq) const {
        const int row0 = u.pm * BM + wr * 64 + fr, col0 = u.pn * BM + wc * 32 + 4 * fq;
        const int cond = u.pm < 32 ? 0 : (u.pm < 48 ? 1 : 2);
        const float* gp = gate + (size_t)cond * gstride + col0;
        f32x4 gv[2][2];
#pragma unroll
        for (int bj = 0; bj < 2; ++bj)
#pragma unroll
            for (int n = 0; n < 2; ++n) gv[bj][n] = *(const f32x4*)(gp + bj * HALF + n * 16) * coef;
#pragma unroll
        for (int ai = 0; ai < 2; ++ai)
#pragma unroll
            for (int m = 0; m < 4; ++m) { float* rowp = X + (size_t)(row0 + ai * HALF + m * 16) * ldc + col0;
#pragma unroll
                for (int bj = 0; bj < 2; ++bj)
#pragma unroll
                    for (int n = 0; n < 2; ++n) { f32x4* p = (f32x4*)(rowp + bj * HALF + n * 16); *p = *p + gv[bj][n] * acc[ai][bj][m][n]; } }
    }
};
struct EpiGLU {
    static constexpr bool PERM = true, AFTER_DRAIN = false;
    const bf16_t* Z; int ldz; const float* bias; bf16_t* O; int ldo;
    __device__ __forceinline__ void operator()(const f32x4 (&acc)[2][2][4][2], const Unit& u, int wr, int wc, int fr, int fq) const {
        const int row0 = u.pm * BM + wr * 64 + fr, col0 = u.pn * BM + wc * 32 + 8 * fq;
        f32x4 bv[2][2];
#pragma unroll
        for (int bj = 0; bj < 2; ++bj)
#pragma unroll
            for (int n = 0; n < 2; ++n) bv[bj][n] = *(const f32x4*)(bias + col0 + bj * HALF + 4 * n);
#pragma unroll
        for (int ai = 0; ai < 2; ++ai)
#pragma unroll
            for (int m = 0; m < 4; ++m) { const size_t row = (size_t)(row0 + ai * HALF + m * 16);
#pragma unroll
                for (int bj = 0; bj < 2; ++bj) { const u32x4 zz = *(const u32x4*)(Z + row * ldz + col0 + bj * HALF);
                    const f32x4 v0 = acc[ai][bj][m][0] + bv[bj][0], v1 = acc[ai][bj][m][1] + bv[bj][1];
                    float zf[8];
#pragma unroll
                    for (int j = 0; j < 4; ++j) { zf[2 * j] = __uint_as_float(zz[j] << 16); zf[2 * j + 1] = __uint_as_float(zz[j] & 0xffff0000u); }
                    float o[8];
#pragma unroll
                    for (int j = 0; j < 4; ++j) { o[j] = zf[j] * fsigmoid(v0[j]); o[4 + j] = zf[4 + j] * fsigmoid(v1[j]); }
                    u32x4 w; w.x = cvt_pk_bf16(o[0], o[1]); w.y = cvt_pk_bf16(o[2], o[3]); w.z = cvt_pk_bf16(o[4], o[5]); w.w = cvt_pk_bf16(o[6], o[7]);
                    *(u32x4*)(O + row * ldo + col0 + bj * HALF) = w; } }
    }
};

template <class Epi, class Sched, bool ALIGN_EPI = false, bool SP2 = false>
__device__ __forceinline__ void gemm_phase(PG8_LAS unsigned char* lds, const Gemm g, const Sched& S, const Epi& E) {
    int tid_ = threadIdx.x; asm volatile("" : "+v"(tid_));
    const int tid = tid_, wid = __builtin_amdgcn_readfirstlane(tid >> 6), lane = tid & 63, wr = wid >> 2, wc = wid & 3, fr = lane & 15, fq = lane >> 4;
    const int K = g.K, nt = K / BK;
    unsigned voffA[2], voffB[2];
#pragma unroll
    for (int i = 0; i < 2; ++i) { int R, C; stage_rc(tid * 16 + i * 8192, R, C); const int Rb = Epi::PERM ? ((R & ~31) + perm32(R & 31)) : R;
        voffA[i] = (unsigned)(R * K + C) * 2u; voffB[i] = (unsigned)(Rb * K + C) * 2u; }
    const size_t kstep = (size_t)(BK * 2);
    const size_t hstep = (size_t)HALF * K * 2;
    const size_t tstep = 2 * hstep;
    const unsigned ldsw = (unsigned)wid * 1024u;
    const int aoff = lds_byte(wr * 64 + fr, fq * 8), boff = lds_byte(wc * 32 + fr, fq * 8);
#define PG8_SA(b, h) (((b) * 2 + (h)) * HTB)
#define PG8_SB(b, h) ((4 + (b) * 2 + (h)) * HTB)
#define PG8_STAGE(bufoff, gbase, voff) do { _Pragma("unroll") for (int _i = 0; _i < 2; ++_i) \
        __builtin_amdgcn_global_load_lds((const unsigned*)((const char*)(gbase) + (voff)[_i]), (PG8_LAS unsigned*)(lds + (bufoff) + ldsw + _i * 8192), 16, 0, 0); } while (0)
#define PG8_LDA(dst, b, h) do { _Pragma("unroll") for (int m = 0; m < 4; ++m) _Pragma("unroll") for (int k = 0; k < 2; ++k) dst[m][k] = *(const PG8_LAS bf16x8*)(lds + PG8_SA(b, h) + aoff + m * 2048 + k * 1024); } while (0)
#define PG8_LDB(dst, b, h) do { _Pragma("unroll") for (int n = 0; n < 2; ++n) _Pragma("unroll") for (int k = 0; k < 2; ++k) dst[n][k] = *(const PG8_LAS bf16x8*)(lds + PG8_SB(b, h) + boff + n * 2048 + k * 1024); } while (0)
#define PG8_MMA(ai, bj, At, Bt) do { __builtin_amdgcn_s_setprio(1); _Pragma("unroll") for (int m = 0; m < 4; ++m) _Pragma("unroll") for (int n = 0; n < 2; ++n) _Pragma("unroll") for (int k = 0; k < 2; ++k) \
        acc[ai][bj][m][n] = __builtin_amdgcn_mfma_f32_16x16x32_bf16(Bt[n][k], At[m][k], acc[ai][bj][m][n], 0, 0, 0); __builtin_amdgcn_s_setprio(0); } while (0)
#define PG8_WAIT_V(n) asm volatile("s_waitcnt vmcnt(" #n ")" ::: "memory")
#define PG8_WAIT_L(n) asm volatile("s_waitcnt lgkmcnt(" #n ")" ::: "memory")
#define PG8_BAR __builtin_amdgcn_s_barrier()
#define PG8_SCHED __builtin_amdgcn_sched_barrier(0)
    Unit cur, nxt; int ui = 0;
    if (!S.next(0, cur)) return;
    f32x4 acc[2][2][4][2];
#pragma unroll
    for (int a = 0; a < 2; ++a)
#pragma unroll
        for (int b = 0; b < 2; ++b)
#pragma unroll
            for (int m = 0; m < 4; ++m)
#pragma unroll
                for (int n = 0; n < 2; ++n) acc[a][b][m][n] = (f32x4){0.f, 0.f, 0.f, 0.f};
    bf16x8 At[4][2], B0[2][2], B1[2][2];
    const char* cA = (const char*)g.A + (size_t)cur.pm * tstep; const char* cB = (const char*)g.Bt + (size_t)cur.pn * tstep;
    S.a_ready(cur);
    if constexpr (SP2) {
        PG8_STAGE(PG8_SB(0, 0), cB, voffB); PG8_STAGE(PG8_SB(0, 1), cB + hstep, voffB); PG8_STAGE(PG8_SA(0, 0), cA, voffA); PG8_STAGE(PG8_SA(0, 1), cA + hstep, voffA);
        if (wr == 1) PG8_BAR;
        PG8_WAIT_V(2); PG8_BAR;
        PG8_STAGE(PG8_SB(1, 0), cB + kstep, voffB); PG8_STAGE(PG8_SA(1, 0), cA + kstep, voffA); PG8_STAGE(PG8_SB(1, 1), cB + hstep + kstep, voffB);
        PG8_WAIT_V(6); PG8_BAR;
    } else {
        PG8_STAGE(PG8_SB(0, 0), cB, voffB); PG8_STAGE(PG8_SA(0, 0), cA, voffA); PG8_STAGE(PG8_SB(0, 1), cB + hstep, voffB); PG8_STAGE(PG8_SA(0, 1), cA + hstep, voffA);
        if (wr == 1) PG8_BAR;
        PG8_WAIT_V(4); PG8_BAR;
        PG8_STAGE(PG8_SB(1, 0), cB + kstep, voffB); PG8_STAGE(PG8_SA(1, 0), cA + kstep, voffA); PG8_STAGE(PG8_SB(1, 1), cB + hstep + kstep, voffB);
        PG8_WAIT_V(6); PG8_BAR;
    }
    for (;;) {
        const bool has_next = S.next(ui + 1, nxt);
        const char* nA = has_next ? (const char*)g.A + (size_t)nxt.pm * tstep : cA; const char* nB = has_next ? (const char*)g.Bt + (size_t)nxt.pn * tstep : cB;
        for (int t = 0; t < nt; t += 2) {
            const bool last = (t == nt - 2);
            const char* a1 = cA + (size_t)(t + 1) * kstep;
            const char* a2 = last ? nA : cA + (size_t)(t + 2) * kstep; const char* b2 = last ? nB : cB + (size_t)(t + 2) * kstep;
            const char* a3 = a2 + kstep; const char* b3 = b2 + kstep;
            if (last && has_next) S.a_ready(nxt);
            if constexpr (SP2) {
            PG8_LDB(B0, 0, 0); PG8_LDB(B1, 0, 1); PG8_SCHED; PG8_LDA(At, 0, 0); PG8_STAGE(PG8_SA(1, 1), a1 + hstep, voffA);
            PG8_WAIT_V(8); PG8_WAIT_L(0); PG8_BAR; PG8_MMA(0, 0, At, B0); PG8_MMA(0, 1, At, B1); PG8_BAR; PG8_SCHED;
            PG8_LDA(At, 0, 1); PG8_STAGE(PG8_SB(0, 0), b2, voffB); PG8_STAGE(PG8_SB(0, 1), b2 + hstep, voffB); PG8_STAGE(PG8_SA(0, 0), a2, voffA);
            PG8_WAIT_V(8); PG8_WAIT_L(0); PG8_BAR; PG8_MMA(1, 0, At, B0); PG8_MMA(1, 1, At, B1); PG8_BAR; PG8_SCHED;
            PG8_LDB(B0, 1, 0); PG8_LDB(B1, 1, 1); PG8_SCHED; PG8_LDA(At, 1, 0); PG8_STAGE(PG8_SA(0, 1), a2 + hstep, voffA);
            PG8_WAIT_V(8); PG8_WAIT_L(0); PG8_BAR; PG8_MMA(0, 0, At, B0); PG8_MMA(0, 1, At, B1); PG8_BAR; PG8_SCHED;
            PG8_LDA(At, 1, 1); PG8_STAGE(PG8_SB(1, 0), b3, voffB); PG8_STAGE(PG8_SB(1, 1), b3 + hstep, voffB); PG8_STAGE(PG8_SA(1, 0), a3, voffA);
            PG8_WAIT_V(8); PG8_WAIT_L(0); PG8_BAR; PG8_MMA(1, 0, At, B0); PG8_MMA(1, 1, At, B1); PG8_BAR; PG8_SCHED;
            } else {
            PG8_LDB(B0, 0, 0); PG8_SCHED; PG8_LDA(At, 0, 0); PG8_STAGE(PG8_SA(1, 1), a1 + hstep, voffA);
            PG8_WAIT_L(8); PG8_BAR; PG8_WAIT_L(0); PG8_MMA(0, 0, At, B0); PG8_BAR; PG8_SCHED;
            PG8_LDB(B1, 0, 1); PG8_STAGE(PG8_SB(0, 0), b2, voffB);
            PG8_BAR; PG8_WAIT_L(0); PG8_MMA(0, 1, At, B1); PG8_BAR;
            PG8_LDA(At, 0, 1); PG8_STAGE(PG8_SA(0, 0), a2, voffA);
            PG8_BAR; PG8_WAIT_L(0); PG8_MMA(1, 0, At, B0); PG8_BAR; PG8_SCHED;
            PG8_STAGE(PG8_SB(0, 1), b2 + hstep, voffB);
            PG8_WAIT_V(6); PG8_BAR; PG8_MMA(1, 1, At, B1); PG8_BAR;
            PG8_LDB(B0, 1, 0); PG8_SCHED; PG8_LDA(At, 1, 0); PG8_STAGE(PG8_SA(0, 1), a2 + hstep, voffA);
            PG8_WAIT_L(8); PG8_BAR; PG8_WAIT_L(0); PG8_MMA(0, 0, At, B0); PG8_BAR; PG8_SCHED;
            PG8_LDB(B1, 1, 1); PG8_STAGE(PG8_SB(1, 0), b3, voffB);
            PG8_BAR; PG8_WAIT_L(0); PG8_MMA(0, 1, At, B1); PG8_BAR;
            PG8_LDA(At, 1, 1); PG8_STAGE(PG8_SA(1, 0), a3, voffA);
            PG8_BAR; PG8_WAIT_L(0); PG8_MMA(1, 0, At, B0); PG8_BAR; PG8_SCHED;
            PG8_STAGE(PG8_SB(1, 1), b3 + hstep, voffB);
            PG8_WAIT_V(6); PG8_BAR; PG8_MMA(1, 1, At, B1); PG8_BAR;
            }
        }
        if constexpr (ALIGN_EPI) { if (wr == 0) PG8_BAR; }
        if constexpr (!Epi::AFTER_DRAIN) { E(acc, cur, wr, wc, fr, fq); S.done(cur); }
        if (!has_next) break;
#pragma unroll
        for (int a = 0; a < 2; ++a)
#pragma unroll
            for (int b = 0; b < 2; ++b)
#pragma unroll
                for (int m = 0; m < 4; ++m)
#pragma unroll
                    for (int n = 0; n < 2; ++n) acc[a][b][m][n] = (f32x4){0.f, 0.f, 0.f, 0.f};
        cur = nxt; cA = nA; cB = nB; ++ui;
        if constexpr (ALIGN_EPI) { if (wr == 1) PG8_BAR; }
    }
    PG8_WAIT_V(0);
    if constexpr (!ALIGN_EPI) { if (wr == 0) PG8_BAR; }
    PG8_BAR;
    if constexpr (Epi::AFTER_DRAIN) { E.fused(acc, cur, wr, wc, fr, fq, lds, wid, lane); S.done(cur); }
#undef PG8_SA
#undef PG8_SB
#undef PG8_STAGE
#undef PG8_LDA
#undef PG8_LDB
#undef PG8_MMA
#undef PG8_WAIT_V
#undef PG8_WAIT_L
#undef PG8_BAR
#undef PG8_SCHED
}
}
#ifndef PG8_SP2
#define PG8_SP2 true
#endif
#ifndef PG8_ALIGN
#define PG8_ALIGN true
#endif
#ifndef MK_PER_PHASE
#define MK_PER_PHASE 0
#endif

constexpr int DM = 2048, DFF = 5632, NMOD = 9, DEPTH = 4;
constexpr int NP_B = 32, NP_L = 256, NS_B = 2, NS_L = 4096, PAST = 512;
constexpr int TP = NP_B * NP_L, TS = NS_B * NS_L, T = TP + TS;
constexpr int HALFW = 1024;
constexpr int S5_G = 64, S5_H = 16, S5_P = 64;
constexpr int HY_EMB = 33, HY_FFN = 64, HY_BANDS = 16;
constexpr int RG_NB = 16, RG_BW = 64;
constexpr int NA_H = 16, NA_HD = 64, GRID_W = 64, GRID_R = 64, WIN_R = 8, WIN_C = 16;
constexpr int EVEN_IN = 4096, ODD_IN = 5120;
constexpr float EPS = 1e-6f;
constexpr int NWAVES = 8, NTHR = 512;

constexpr size_t MiB = 1u << 20;
constexpr size_t WS_CTL = 0, CTL_ZERO_BYTES = 1 * MiB;
constexpr size_t WS_MODP = 1 * MiB;
constexpr size_t WS_MOD  = 9 * MiB;
constexpr size_t WS_S5A  = 10 * MiB;
constexpr size_t WS_S5BB = 11 * MiB;
constexpr size_t WS_HYNP = 24 * MiB;
constexpr size_t WS_HYIN = 28 * MiB;
constexpr size_t WS_RGS  = 16 * MiB;
constexpr size_t WS_S5E  = 20 * MiB;
constexpr size_t WS_WGU  = 32 * MiB;
constexpr size_t WS_WD   = 384 * MiB;
constexpr size_t WS_WINE = 560 * MiB;
constexpr size_t WS_WINO = 592 * MiB;
constexpr size_t WS_WOUT = 632 * MiB;
constexpr size_t WS_WGLU = 664 * MiB;
constexpr size_t WS_KF   = 672 * MiB;
constexpr size_t KF_EI_BYTES = 68 * MiB, KF_SMALL_OFF = 64 * MiB;
constexpr size_t WS_H    = 808 * MiB;
constexpr size_t WS_A1   = 872 * MiB;
constexpr size_t WS_PROJ = 1048 * MiB;
constexpr size_t PROJT_OFF = 64 * MiB;
constexpr size_t WS_MIX  = 1368 * MiB;
constexpr size_t WS_Z    = 1432 * MiB;
constexpr size_t WS_ZT   = 1464 * MiB;
constexpr size_t WS_AB   = 1528 * MiB;
constexpr size_t WS_QN   = 1784 * MiB;
constexpr size_t WS_KN   = 1848 * MiB;
constexpr size_t WS_END  = 1912 * MiB;
constexpr int CW_BAR = 4096;

constexpr size_t OUT_YP = 0, OUT_YS = (size_t)TP * DM, OUT_NAK = (size_t)T * DM;
constexpr size_t OUT_NAV = OUT_NAK + (size_t)NP_B * 2 * NP_L * 1024;
constexpr size_t OUT_S5 = OUT_NAV + (size_t)NP_B * 2 * NP_L * 1024;
constexpr size_t OUT_RG = OUT_S5 + (size_t)NP_B * 2 * 2 * 64 * 64 * 2;
constexpr size_t OUT_END = OUT_RG + (size_t)NP_B * 2 * 2 * 1024;

constexpr int RING_OFF = 0, RING_BYTES = 131072;
constexpr int LDSCTL_OFF = RING_BYTES, MISC_OFF = LDSCTL_OFF + 320;
constexpr int LDS_BYTES = 147456;

#define GAS __attribute__((address_space(1)))
#define LAS __attribute__((address_space(3)))
typedef unsigned short bf16;
typedef unsigned v4u __attribute__((ext_vector_type(4)));
typedef unsigned v2u __attribute__((ext_vector_type(2)));
typedef float f32x4 __attribute__((ext_vector_type(4)));
typedef float f32x2 __attribute__((ext_vector_type(2)));
typedef short bf16x8 __attribute__((ext_vector_type(8)));
typedef GAS unsigned gu32;
#define RLX_AGENT __ATOMIC_RELAXED, __HIP_MEMORY_SCOPE_AGENT
#define LDS_WAIT() asm volatile("s_waitcnt lgkmcnt(0)" ::: "memory")
#define VM_WAIT() asm volatile("s_waitcnt vmcnt(0)" ::: "memory")
__device__ __forceinline__ unsigned f2bf(float f) { unsigned u = __builtin_bit_cast(unsigned, f); return (u + 0x7fffu + ((u >> 16) & 1u)) >> 16; }
__device__ __forceinline__ unsigned pk2(float lo, float hi) { return f2bf(lo) | (f2bf(hi) << 16); }
__device__ __forceinline__ float bf2f(unsigned short b) { return __uint_as_float(((unsigned)b) << 16); }
__device__ __forceinline__ float sigmoidf_(float x) { return 1.0f / (1.0f + __expf(-x)); }
__device__ __forceinline__ float siluf_(float x) { return x * sigmoidf_(x); }
__device__ __forceinline__ float gelu_tanh(float x) { const float u = 0.7978845608028654f * (x + 0.044715f * x * x * x); return x * sigmoidf_(2.0f * u); }
__device__ __forceinline__ float wave_sum(float v) {
#pragma unroll
    for (int o = 1; o < 64; o <<= 1) v += __shfl_xor(v, o);
    return v;
}
__device__ __forceinline__ float wave_max(float v) {
#pragma unroll
    for (int o = 1; o < 64; o <<= 1) v = fmaxf(v, __shfl_xor(v, o));
    return v;
}

#define XB_TMO      128
#define XB_XCNT(j)  (256  + 64 * (j))
#define XB_XSUB(j)  (1280 + 64 * (j))
#define XB_XGEN(j)  (2304 + 64 * (j))
#define XB_TOP      3328
#define XB_TOPGEN   3392
#define XCD_BAR_WORDS 3456
#define XB_SPIN_CAP (1u << 18)
__device__ __forceinline__ unsigned xb_ld(unsigned* p)              { return __hip_atomic_load(p, __ATOMIC_RELAXED, __HIP_MEMORY_SCOPE_AGENT); }
__device__ __forceinline__ unsigned xb_add(unsigned* p, unsigned v) { return __hip_atomic_fetch_add(p, v, __ATOMIC_RELAXED, __HIP_MEMORY_SCOPE_AGENT); }
__device__ __forceinline__ unsigned xb_xcc_id() { return (unsigned)__builtin_amdgcn_s_getreg((3 << 11) | 20) & 0xFu; }
#define XB_SPIN(cond, bar) do { unsigned _sp = 0; while (cond) { __builtin_amdgcn_s_sleep(1); \
    if ((++_sp & 255u) == 0u) { if (xb_ld(&(bar)[XB_TMO])) break; if (_sp > XB_SPIN_CAP) { atomicAdd(&(bar)[XB_TMO], 1u); break; } } } } while (0)
struct XcdBarrier { unsigned* bar; unsigned x; volatile LAS unsigned* st; };
__device__ __forceinline__ XcdBarrier xcd_barrier_post(unsigned* bar, volatile LAS unsigned* st) {
    XcdBarrier b; b.bar = bar; b.x = xb_xcc_id(); b.st = st;
    if (threadIdx.x == 0) (void)xb_add(&bar[XB_XCNT(b.x)], 1u);
    return b;
}
__device__ __forceinline__ void xcd_barrier_complete(unsigned* bar, unsigned x, unsigned& nloc, unsigned& nx) {
    const unsigned G = gridDim.x * gridDim.y * gridDim.z;
    unsigned sum, cnt, mine, sp = 0u;
    for (;;) {
        sum = 0u; cnt = 0u; mine = 0u;
#pragma unroll
        for (unsigned j = 0; j < 16; ++j) { const unsigned c = xb_ld(&bar[XB_XCNT(j)]); sum += c; cnt += (c > 0u) ? 1u : 0u; mine = (j == x) ? c : mine; }
        if (sum == G) break;
        __builtin_amdgcn_s_sleep(1);
        if ((++sp & 255u) == 0u) { if (xb_ld(&bar[XB_TMO])) break; if (sp > XB_SPIN_CAP) { atomicAdd(&bar[XB_TMO], 1u); break; } }
    }
    nloc = mine > 0u ? mine : 1u; nx = cnt > 0u ? cnt : 1u;
}
__device__ __forceinline__ void xcd_barrier(const XcdBarrier& b) {
    asm volatile("s_waitcnt vmcnt(0)" ::: "memory");
    __syncthreads();
    if (threadIdx.x == 0) {
        unsigned* bar = b.bar; unsigned bx = b.x;
        asm volatile("" : "+s"(bar), "+s"(bx));
        __builtin_amdgcn_s_waitcnt(0);
        unsigned nloc = b.st[0], nx = b.st[1];
        if (nloc == 0u) { xcd_barrier_complete(bar, bx, nloc, nx); b.st[0] = nloc; b.st[1] = nx; }
        const unsigned old = xb_add(&bar[XB_XSUB(bx)], 1u);
        const unsigned gen = old / nloc;
        if (old + 1u == (gen + 1u) * nloc) {
            __builtin_amdgcn_fence(__ATOMIC_RELEASE, "agent");
            asm volatile("s_waitcnt vmcnt(0)" ::: "memory");
            const unsigned og = xb_add(&bar[XB_TOP], 1u);
            const unsigned tg = og / nx;
            if (og + 1u == (tg + 1u) * nx) xb_add(&bar[XB_TOPGEN], 1u);
            else XB_SPIN(xb_ld(&bar[XB_TOPGEN]) == tg, bar);
            __builtin_amdgcn_fence(__ATOMIC_ACQUIRE, "agent");
            xb_add(&bar[XB_XGEN(bx)], 1u);
            asm volatile("s_waitcnt vmcnt(0)" ::: "memory");
        } else {
            XB_SPIN(xb_ld(&bar[XB_XGEN(bx)]) == gen, bar);
            __builtin_amdgcn_fence(__ATOMIC_ACQUIRE, "agent");
            asm volatile("s_waitcnt vmcnt(0)" ::: "memory");
        }
    }
    __syncthreads();
}

struct Frame {
    LAS unsigned char* lds;
    int tid, lane, wave;
    int vcu, G;
    int gw, NGW;
};
enum { I_XP = 0, I_XS, I_CK, I_CV, I_SS5, I_SRG, I_C, I_CCTX, I_NG, I_MODW, I_MODB, I_WG, I_WU, I_WD, I_EWIN, I_EWOUT,
       I_S5LRE, I_S5LIM, I_S5LDT, I_S5BRE, I_S5BIM, I_S5CRE, I_S5CIM, I_S5D, I_S5GLUW, I_S5GLUB,
       I_HYCW, I_HYCB, I_HYW1, I_HYB1, I_HYW2, I_HYB2, I_HYW3, I_HYFREQ, I_HYDEC, I_HYBIAS,
       I_OWIN, I_OWOUT, I_RGCW, I_RGCB, I_RGWA, I_RGBA, I_RGWI, I_RGBI, I_RGLAM, I_NAQN, I_NAKN, I_NARPB, N_IN };
struct Args { const float* in[N_IN]; float* out; unsigned char* ws; int ph_lo, ph_hi; };

__device__ __forceinline__ int seq_row0(int sq) { return sq < NP_B ? sq * NP_L : TP + (sq - NP_B) * NS_L; }
__device__ __forceinline__ int seq_len(int sq) { return sq < NP_B ? NP_L : NS_L; }
__device__ __forceinline__ int row_cond(int row) { return row < TP ? 0 : (row < TP + NS_L ? 1 : 2); }
__device__ __forceinline__ void p0_transpose_item(const float* W, int K, int N, bf16* WT, int mode, LAS float* scr, int item, int lane) {
    const int nblk = N / 32, kb = item / nblk, nb = item % nblk, k0 = 64 * kb, n0 = 32 * nb;
#pragma unroll 8
    for (int i = 0; i < 32; ++i) { const int kk = 2 * i + (lane >> 5); scr[kk * 33 + (lane & 31)] = W[(size_t)(k0 + kk) * N + n0 + (lane & 31)]; }
    LDS_WAIT(); asm volatile("" ::: "memory");
    const int c = lane & 7;
    const int rbase = (mode == 0) ? n0 : ((n0 >> 7) * 256 + (n0 & 127) + (mode == 2 ? 128 : 0));
#pragma unroll
    for (int j = 0; j < 4; ++j) { const int n = (lane >> 3) + 8 * j; const LAS float* s = scr + (8 * c) * 33 + n;
        v4u o; o.x = pk2(s[0 * 33], s[1 * 33]); o.y = pk2(s[2 * 33], s[3 * 33]); o.z = pk2(s[4 * 33], s[5 * 33]); o.w = pk2(s[6 * 33], s[7 * 33]);
        *(GAS v4u*)(WT + (size_t)(rbase + n) * K + k0 + 8 * c) = o; }
    LDS_WAIT(); asm volatile("" ::: "memory");
}

__device__ __forceinline__ void p0_weights(const Args& a, Frame& F) {
    LAS float* scr = (LAS float*)(F.lds + RING_OFF + F.wave * 16384);
    unsigned char* ws = a.ws;
    constexpr int IT_F = 5632;
    constexpr int N_FFN = 24 * IT_F;
    constexpr int IT_EIN = 32 * 128, IT_OIN = 32 * 160, IT_OUT = 32 * 64, IT_GLU = 16 * 32;
    constexpr int NITEMS = N_FFN + 2 * (IT_EIN + IT_OIN + 2 * IT_OUT + IT_GLU);
    for (int it = F.gw; it < NITEMS; it += F.NGW) {
        int r = it;
        if (r < N_FFN) {
            const int mi = r / IT_F, li = r % IT_F;
            if (mi < 8)       p0_transpose_item(a.in[I_WG] + (size_t)mi * DM * DFF, DM, DFF, (bf16*)(ws + WS_WGU) + (size_t)mi * 2 * DFF * DM, 1, scr, li, F.lane);
            else if (mi < 16) p0_transpose_item(a.in[I_WU] + (size_t)(mi - 8) * DM * DFF, DM, DFF, (bf16*)(ws + WS_WGU) + (size_t)(mi - 8) * 2 * DFF * DM, 2, scr, li, F.lane);
            else              p0_transpose_item(a.in[I_WD] + (size_t)(mi - 16) * DFF * DM, DFF, DM, (bf16*)(ws + WS_WD) + (size_t)(mi - 16) * DM * DFF, 0, scr, li, F.lane);
            continue;
        }
        r -= N_FFN;
        if (r < 2 * IT_EIN) { const int e = r / IT_EIN; p0_transpose_item(a.in[I_EWIN] + (size_t)e * DM * EVEN_IN, DM, EVEN_IN, (bf16*)(ws + WS_WINE) + (size_t)e * EVEN_IN * DM, 0, scr, r % IT_EIN, F.lane); continue; }
        r -= 2 * IT_EIN;
        if (r < 2 * IT_OIN) { const int e = r / IT_OIN; p0_transpose_item(a.in[I_OWIN] + (size_t)e * DM * ODD_IN, DM, ODD_IN, (bf16*)(ws + WS_WINO) + (size_t)e * ODD_IN * DM, 0, scr, r % IT_OIN, F.lane); continue; }
        r -= 2 * IT_OIN;
        if (r < 2 * IT_OUT) { const int e = r / IT_OUT; p0_transpose_item(a.in[I_EWOUT] + (size_t)e * DM * DM, DM, DM, (bf16*)(ws + WS_WOUT) + (size_t)(2 * e) * DM * DM, 0, scr, r % IT_OUT, F.lane); continue; }
        r -= 2 * IT_OUT;
        if (r < 2 * IT_OUT) { const int e = r / IT_OUT; p0_transpose_item(a.in[I_OWOUT] + (size_t)e * DM * DM, DM, DM, (bf16*)(ws + WS_WOUT) + (size_t)(2 * e + 1) * DM * DM, 0, scr, r % IT_OUT, F.lane); continue; }
        r -= 2 * IT_OUT;
        { const int e = r / IT_GLU; p0_transpose_item(a.in[I_S5GLUW] + (size_t)e * HALFW * HALFW, HALFW, HALFW, (bf16*)(ws + WS_WGLU) + (size_t)e * HALFW * HALFW, 0, scr, r % IT_GLU, F.lane); }
    }
}

__device__ __forceinline__ void p0_copy_x(const Args& a, Frame& F) {
    const size_t n4 = (size_t)T * DM / 4, np4 = (size_t)TP * DM / 4;
    const GAS f32x4* xp = (const GAS f32x4*)a.in[I_XP]; const GAS f32x4* xs = (const GAS f32x4*)a.in[I_XS]; GAS f32x4* o = (GAS f32x4*)a.out;
    for (size_t i = (size_t)F.vcu * NTHR + F.tid; i < n4; i += (size_t)F.G * NTHR) o[i] = i < np4 ? xp[i] : xs[i - np4];
}

__device__ __forceinline__ void p0_adaln(const Args& a, Frame& F) {
    LAS float* scr = (LAS float*)(F.lds + RING_OFF + F.wave * 16384);
    const float* modw = a.in[I_MODW]; float* modp = (float*)(a.ws + WS_MODP);
    constexpr int NC = NMOD * DM;
    for (int it = F.gw; it < 4 * 72 * 8; it += F.NGW) {
        const int li = it / 576, r0 = it % 576, cc = r0 / 8, ks = r0 % 8, k0 = ks * 256, col = cc * 256 + F.lane * 4;
#pragma unroll
        for (int q = 0; q < 4; ++q) { const int k = k0 + F.lane + 64 * q;
            scr[F.lane + 64 * q] = siluf_(a.in[I_CCTX][k]); scr[256 + F.lane + 64 * q] = siluf_(a.in[I_C][k]); scr[512 + F.lane + 64 * q] = siluf_(a.in[I_C][DM + k]); }
        LDS_WAIT(); asm volatile("" ::: "memory");
        f32x4 a0 = {0.f, 0.f, 0.f, 0.f}, a1 = a0, a2 = a0;
        const float* wp = modw + ((size_t)li * DM + k0) * NC + col;
#pragma unroll 8
        for (int k = 0; k < 256; ++k) { const f32x4 w = *(const GAS f32x4*)(wp + (size_t)k * NC); a0 += scr[k] * w; a1 += scr[256 + k] * w; a2 += scr[512 + k] * w; }
        float* dst = modp + ((size_t)(ks * 4 + li) * 3) * NC + col;
        *(GAS f32x4*)(dst) = a0; *(GAS f32x4*)(dst + NC) = a1; *(GAS f32x4*)(dst + 2 * NC) = a2;
        LDS_WAIT(); asm volatile("" ::: "memory");
    }
}
__device__ __forceinline__ void p0b_adaln_final(const Args& a, Frame& F) {
    constexpr int NC = NMOD * DM, NTOT = 4 * 3 * NC;
    const float* modp = (const float*)(a.ws + WS_MODP); float* mod = (float*)(a.ws + WS_MOD);
    for (int i = (F.vcu * NTHR + F.tid) * 4; i < NTOT; i += F.G * NTHR * 4) {
        const int li = i / (3 * NC), j = i % NC;
        f32x4 s = *(const GAS f32x4*)(a.in[I_MODB] + (size_t)li * NC + j);
#pragma unroll
        for (int ks = 0; ks < 8; ++ks) s += *(const GAS f32x4*)(modp + (size_t)ks * NTOT + i);
        *(GAS f32x4*)(mod + i) = s;
    }
}

__device__ __forceinline__ void p0_s5params(const Args& a, Frame& F) {
    float* SA = (float*)(a.ws + WS_S5A); float* SBB = (float*)(a.ws + WS_S5BB);
    for (int i = F.vcu * NTHR + F.tid; i < 2 * 2 * S5_G * S5_P; i += F.G * NTHR) {
        const int edg = i / S5_P;
        const float lr = fminf(a.in[I_S5LRE][i], -1e-4f), li = a.in[I_S5LIM][i], dt = expf(a.in[I_S5LDT][edg]);
        const float mag = expf(lr * dt), abr = mag * cosf(li * dt), abi = mag * sinf(li * dt);
        const float den = lr * lr + li * li;
        const float cr = ((abr - 1.0f) * lr + abi * li) / den, ci = (abi * lr - (abr - 1.0f) * li) / den;
        SA[2 * i] = abr; SA[2 * i + 1] = abi;
#pragma unroll 4
        for (int h = 0; h < S5_H; ++h) { const float br = a.in[I_S5BRE][(size_t)i * S5_H + h], bi = a.in[I_S5BIM][(size_t)i * S5_H + h];
            SBB[((size_t)i * S5_H + h) * 2] = cr * br - ci * bi; SBB[((size_t)i * S5_H + h) * 2 + 1] = cr * bi + ci * br; }
    }
}

__device__ __forceinline__ void p0_hyena_filters(const Args& a, Frame& F) {
    LAS float* h1s = (LAS float*)(F.lds + RING_OFF + F.wave * 16384);
    constexpr int NIT = 2 * 68 * 16;
    for (int it = F.gw; it < NIT; it += F.NGW) {
        const int ei = it / (68 * 16), r0 = it % (68 * 16), ttg = r0 / 16, ct = r0 % 16;
        const int Lsel = ttg < 64 ? 0 : 1, tt = ttg < 64 ? ttg : ttg - 64, L = Lsel == 0 ? NS_L : NP_L;
        const int t = tt * 64 + F.lane;
        const float tf = (float)t, t01 = tf / (float)L;
        const float* w1 = a.in[I_HYW1] + (size_t)ei * HY_EMB * HY_FFN; const float* b1 = a.in[I_HYB1] + ei * HY_FFN;
        const float* w2 = a.in[I_HYW2] + (size_t)ei * HY_FFN * HY_FFN; const float* b2 = a.in[I_HYB2] + ei * HY_FFN;
        const float* w3 = a.in[I_HYW3] + (size_t)ei * HY_FFN * 4096; const float* fr = a.in[I_HYFREQ] + ei * HY_FFN;
        const float* dec = a.in[I_HYDEC] + (size_t)ei * 4096;
        {
            float z[HY_EMB]; z[0] = t01;
            const float cang = (float)(2.0 * 3.14159265358979323846 / (double)L) * tf;
#pragma unroll
            for (int b = 0; b < HY_BANDS; ++b) { const float band = 1e-4f + (float)b * ((15.0f - 1e-4f) / 15.0f); const float ang = cang * band; z[1 + b] = cosf(ang); z[17 + b] = -sinf(ang); }
            for (int j = 0; j < HY_FFN; ++j) { float s = b1[j];
#pragma unroll
                for (int e = 0; e < HY_EMB; ++e) s += z[e] * w1[e * HY_FFN + j];
                h1s[j * 64 + F.lane] = sinf(fr[j] * s); }
        }
        LDS_WAIT(); asm volatile("" ::: "memory");
        float h2[HY_FFN];
#pragma unroll
        for (int j = 0; j < HY_FFN; ++j) h2[j] = b2[j];
        for (int k = 0; k < HY_FFN; ++k) { const float hk = h1s[k * 64 + F.lane];
#pragma unroll
            for (int j = 0; j < HY_FFN; ++j) h2[j] += hk * w2[k * HY_FFN + j]; }
        LDS_WAIT(); asm volatile("" ::: "memory");
#pragma unroll
        for (int j = 0; j < HY_FFN; ++j) h1s[j * 64 + F.lane] = h2[j];
        LDS_WAIT(); asm volatile("" ::: "memory");
        for (int j = 0; j < HY_FFN; ++j) h1s[j * 64 + F.lane] = sinf(fr[j] * h1s[j * 64 + F.lane]);
        LDS_WAIT(); asm volatile("" ::: "memory");
        float* kf = (float*)(a.ws + WS_KF + (size_t)ei * KF_EI_BYTES + (Lsel ? KF_SMALL_OFF : 0));
        float* np = (float*)(a.ws + WS_HYNP) + ((size_t)((ei * 2 + Lsel) * 64 + tt)) * 4096;
        for (int c8 = 0; c8 < 256; c8 += 8) {
            const int colg = ct * 256 + c8;
            float acc[8];
#pragma unroll
            for (int q = 0; q < 8; ++q) acc[q] = 0.f;
#pragma unroll 4
            for (int j = 0; j < HY_FFN; ++j) { const float hj = h1s[j * 64 + F.lane];
#pragma unroll
                for (int q = 0; q < 8; ++q) acc[q] += hj * w3[(size_t)j * 4096 + colg + q]; }
#pragma unroll
            for (int q = 0; q < 8; ++q) {
                const int cg = colg + q, n = cg >> 11, dir = (cg >> 10) & 1, c = cg & 1023;
                float v = acc[q] * expf(-t01 * fabsf(dec[cg]));
                float* kp = kf + ((size_t)(n * 1024 + c)) * (2 * L);
                if (dir == 0) kp[L + t] = v; else { if (t == 0) { kp[0] = 0.f; v = 0.f; } else kp[L - t] = v; }
                const float sabs = wave_sum(fabsf(v));
                if (F.lane == 0) np[cg] = sabs;
            }
        }
        LDS_WAIT(); asm volatile("" ::: "memory");
    }
}
__device__ __forceinline__ void p0b_hyena_norm(const Args& a, Frame& F) {
    const float* np = (const float*)(a.ws + WS_HYNP); float* inv = (float*)(a.ws + WS_HYIN);
    for (int i = F.vcu * NTHR + F.tid; i < 2 * 2 * 2 * 1024; i += F.G * NTHR) {
        const int el = i >> 11, n = (i >> 10) & 1, c = i & 1023, ntt = (el & 1) ? 4 : 64;
        float s = 0.f;
        for (int tt = 0; tt < ntt; ++tt) { const float* p = np + ((size_t)(el * 64 + tt)) * 4096 + (n * 2) * 1024 + c; s += p[0] + p[1024]; }
        inv[i] = 1.0f / s;
    }
}
__device__ __forceinline__ void phase_norm(const Args& a, Frame& F, const float* g, const float* shift, const float* scale) {
    const float* X = a.out; bf16* H = (bf16*)(a.ws + WS_H);
    for (int row = F.gw; row < T; row += F.NGW) {
        const int cond = row_cond(row);
        const GAS f32x4* xr = (const GAS f32x4*)(X + (size_t)row * DM) + F.lane;
        f32x4 v[8]; float ss = 0.f;
#pragma unroll
        for (int j = 0; j < 8; ++j) { v[j] = xr[64 * j]; ss += (v[j].x * v[j].x + v[j].y * v[j].y) + (v[j].z * v[j].z + v[j].w * v[j].w); }
        const float rstd = 1.0f / sqrtf(wave_sum(ss) * (1.0f / DM) + EPS);
        const float* sh = shift + (size_t)cond * NMOD * DM; const float* sc = scale + (size_t)cond * NMOD * DM;
        GAS v2u* o8 = (GAS v2u*)(H + (size_t)row * DM) + F.lane;
#pragma unroll
        for (int j = 0; j < 8; ++j) { const int col = (F.lane + 64 * j) * 4;
            const f32x4 gg = *(const GAS f32x4*)(g + col), s1 = *(const GAS f32x4*)(sc + col), s0 = *(const GAS f32x4*)(sh + col);
            const f32x4 y = (v[j] * rstd) * gg * (s1 + 1.0f) + s0;
            v2u w; w.x = pk2(y.x, y.y); w.y = pk2(y.z, y.w); o8[64 * j] = w; }
    }
}

__device__ __forceinline__ void s5_pass1(const Args& a, Frame& F, int ei) {
    const float* U = (const float*)(a.ws + WS_PROJ);
    const float* SA = (const float*)(a.ws + WS_S5A); const float* SBB = (const float*)(a.ws + WS_S5BB); float* SE = (float*)(a.ws + WS_S5E);
    for (int it = F.gw; it < 2 * 16 * 2 * S5_G; it += F.NGW) {
        const int g = it & 63, d = (it >> 6) & 1, c = (it >> 7) & 15, s = it >> 11;
        const int pidx = ((ei * 2 + d) * S5_G + g) * S5_P + F.lane;
        const float ar = SA[2 * pidx], ai = SA[2 * pidx + 1];
        float bbr[S5_H], bbi[S5_H];
#pragma unroll
        for (int h = 0; h < S5_H; ++h) { const f32x2 b = *(const GAS f32x2*)(SBB + ((size_t)pidx * S5_H + h) * 2); bbr[h] = b.x; bbi[h] = b.y; }
        const int row0 = TP + s * NS_L + c * 256;
        float hr = 0.f, hi = 0.f;
        for (int k = 0; k < 256; ++k) {
            const int row = row0 + (d == 0 ? k : 255 - k);
            const float* up = U + (size_t)row * HALFW + g * S5_H;
            float br = 0.f, bi = 0.f;
#pragma unroll
            for (int h = 0; h < S5_H; ++h) { const float u = up[h]; br += bbr[h] * u; bi += bbi[h] * u; }
            const float nr = ar * hr - ai * hi + br, ni = ar * hi + ai * hr + bi; hr = nr; hi = ni;
        }
        *(GAS f32x2*)(SE + ((size_t)it * S5_P + F.lane) * 2) = (f32x2){hr, hi};
    }
}
__device__ __forceinline__ float reduce_scatter16(const float (&v)[16], int lane) {
    float w8[8], w4[4], w2[2];
    const bool b5 = lane & 32, b4 = lane & 16, b3 = lane & 8, b2 = lane & 4;
#pragma unroll
    for (int i = 0; i < 8; ++i) { const float mine = b5 ? v[8 + i] : v[i], theirs = b5 ? v[i] : v[8 + i]; w8[i] = mine + __shfl_xor(theirs, 32); }
#pragma unroll
    for (int i = 0; i < 4; ++i) { const float mine = b4 ? w8[4 + i] : w8[i], theirs = b4 ? w8[i] : w8[4 + i]; w4[i] = mine + __shfl_xor(theirs, 16); }
#pragma unroll
    for (int i = 0; i < 2; ++i) { const float mine = b3 ? w4[2 + i] : w4[i], theirs = b3 ? w4[i] : w4[2 + i]; w2[i] = mine + __shfl_xor(theirs, 8); }
    const float mine = b2 ? w2[1] : w2[0], theirs = b2 ? w2[0] : w2[1];
    float r = mine + __shfl_xor(theirs, 4);
    r += __shfl_xor(r, 1); r += __shfl_xor(r, 2);
    return r;
}
__device__ __forceinline__ void s5_pass2(const Args& a, Frame& F, int ei) {
    const float* U = (const float*)(a.ws + WS_PROJ);
    const float* SA = (const float*)(a.ws + WS_S5A); const float* SBB = (const float*)(a.ws + WS_S5BB); const float* SE = (const float*)(a.ws + WS_S5E);
    bf16* Z = (bf16*)(a.ws + WS_Z);
    LAS float* ys = (LAS float*)(F.lds + RING_OFF + F.wave * 16384);
    for (int it = F.gw; it < 64 * S5_G; it += F.NGW) {
        const int g = it & 63, ch = it >> 6;
        const int row0 = ch * 256;
        for (int d = 0; d < 2; ++d) {
            const int pidx = ((ei * 2 + d) * S5_G + g) * S5_P + F.lane;
            const float ar = SA[2 * pidx], ai = SA[2 * pidx + 1];
            float bbr[S5_H], bbi[S5_H], cre[S5_H], cim[S5_H];
#pragma unroll
            for (int h = 0; h < S5_H; ++h) { const f32x2 b = *(const GAS f32x2*)(SBB + ((size_t)pidx * S5_H + h) * 2); bbr[h] = b.x; bbi[h] = b.y;
                const size_t ci = ((size_t)((ei * 2 + d) * S5_G + g) * S5_H + h) * S5_P + F.lane; cre[h] = a.in[I_S5CRE][ci]; cim[h] = a.in[I_S5CIM][ci]; }
            float hr = 0.f, hi = 0.f;
            if (ch >= 32) {
                const int s = (ch - 32) >> 4, c = (ch - 32) & 15;
                const f32x2 h0 = *(const GAS f32x2*)(a.in[I_SS5] + ((size_t)(((s * 2 + ei) * 2 + d) * S5_G + g) * S5_P + F.lane) * 2);
                hr = h0.x; hi = h0.y;
                float pr = ar, pi = ai;
#pragma unroll
                for (int q = 0; q < 8; ++q) { const float nr = pr * pr - pi * pi, ni = 2.f * pr * pi; pr = nr; pi = ni; }
                const int nfold = (d == 0) ? c : 15 - c;
                for (int q = 0; q < nfold; ++q) { const int cc = (d == 0) ? q : 15 - q;
                    const f32x2 e = *(const GAS f32x2*)(SE + ((size_t)((((s * 16 + cc) * 2 + d) * S5_G + g) * S5_P) + F.lane) * 2);
                    const float nr = pr * hr - pi * hi + e.x, ni = pr * hi + pi * hr + e.y; hr = nr; hi = ni; }
            }
            for (int k = 0; k < 256; ++k) {
                const int tl = (d == 0) ? k : 255 - k;
                const float* up = U + (size_t)(row0 + tl) * HALFW + g * S5_H;
                float br = 0.f, bi = 0.f;
#pragma unroll
                for (int h = 0; h < S5_H; ++h) { const float u = up[h]; br += bbr[h] * u; bi += bbi[h] * u; }
                const float nr = ar * hr - ai * hi + br, ni = ar * hi + ai * hr + bi; hr = nr; hi = ni;
                float v[16];
#pragma unroll
                for (int h = 0; h < S5_H; ++h) v[h] = cre[h] * hr - cim[h] * hi;
                const float r = reduce_scatter16(v, F.lane);
                if ((F.lane & 3) == 0) { LAS float* yp = ys + tl * 16 + (F.lane >> 2); if (d == 0) *yp = r; else *yp += r; }
            }
            if (ch < 32) *(GAS f32x2*)(a.out + OUT_S5 + ((size_t)(((ch * 2 + ei) * 2 + d) * S5_G + g) * S5_P + F.lane) * 2) = (f32x2){hr, hi};
            LDS_WAIT(); asm volatile("" ::: "memory");
        }
        const float dsk = a.in[I_S5D][(ei * S5_G + g) * S5_H + (F.lane & 15)];
        for (int q = 0; q < 64; ++q) { const int tl = q * 4 + (F.lane >> 4), hh = F.lane & 15; const size_t row = (size_t)(row0 + tl);
            const float y = ys[tl * 16 + hh] + dsk * U[row * HALFW + g * S5_H + hh];
            Z[row * HALFW + g * S5_H + hh] = (bf16)f2bf(gelu_tanh(y)); }
        LDS_WAIT(); asm volatile("" ::: "memory");
    }
}

template <int NW>
__device__ __forceinline__ float hy_short(const float* prow, int t, int L, float w0, float w1, float w2, float cb) {
    const float xm = t > 0 ? prow[t - 1] : 0.f, x0 = prow[t], xp = t < L - 1 ? prow[t + 1] : 0.f;
    return cb + w0 * xm + w1 * x0 + w2 * xp;
}
template <int NW>
__device__ __forceinline__ void hyena_item(const Args& a, int ei, int sq, int c, LAS float* zs, LAS float* ks, LAS float* zn, int tl  ) {
    constexpr int L = NW == 1 ? NP_L : NS_L, NT = NW * 64;
    const int row0 = seq_row0(sq);
    const float* PT = (const float*)(a.ws + WS_PROJ + PROJT_OFF);
    const float* cw = a.in[I_HYCW] + (size_t)ei * 3 * 3072; const float* cbv = a.in[I_HYCB] + (size_t)ei * 3072;
    const float* kf = (const float*)(a.ws + WS_KF + (size_t)ei * KF_EI_BYTES + (NW == 1 ? KF_SMALL_OFF : 0));
    const float* inv = (const float*)(a.ws + WS_HYIN) + (size_t)(ei * 2 + (NW == 1 ? 1 : 0)) * 2048;
    {
        const float* prow = PT + (size_t)c * T + row0; const float w0 = cw[c], w1 = cw[3072 + c], w2 = cw[2 * 3072 + c], cb = cbv[c];
        for (int t = tl; t < L; t += NT) zs[t] = hy_short<NW>(prow, t, L, w0, w1, w2, cb);
    }
    for (int n = 0; n < 2; ++n) {
        const float* kp = kf + ((size_t)(n * 1024 + c)) * (2 * L);
        for (int i = tl; i < 2 * L / 4; i += NT) ((LAS f32x4*)ks)[i] = ((const GAS f32x4*)kp)[i];
        if (NW == 1) { LDS_WAIT(); asm volatile("" ::: "memory"); } else __syncthreads();
        const int x = (1 + n) * 1024 + c;
        const float* grow = PT + (size_t)x * T + row0; const float w0 = cw[x], w1 = cw[3072 + x], w2 = cw[2 * 3072 + x], cb = cbv[x];
        const float bias = a.in[I_HYBIAS][(size_t)(ei * 2 + n) * 1024 + c], invn = inv[n * 1024 + c];
        for (int t0 = 4 * tl; t0 < L; t0 += 4 * NT) {
            float acc[4] = {0.f, 0.f, 0.f, 0.f};
            for (int sg = 0; sg < L / 4; ++sg) {
                const f32x4 zq = ((const LAS f32x4*)zs)[sg];
                const int bi = (t0 - 4 * sg + L) >> 2;
                const f32x4 kh = ((const LAS f32x4*)ks)[bi], kl = ((const LAS f32x4*)ks)[bi - 1];
                const float kk[8] = {kl.x, kl.y, kl.z, kl.w, kh.x, kh.y, kh.z, kh.w};
                const float zz[4] = {zq.x, zq.y, zq.z, zq.w};
#pragma unroll
                for (int i = 0; i < 4; ++i)
#pragma unroll
                    for (int j = 0; j < 4; ++j) acc[i] += kk[4 + i - j] * zz[j];
            }
#pragma unroll
            for (int i = 0; i < 4; ++i) { const int t = t0 + i; const float gate = hy_short<NW>(grow, t, L, w0, w1, w2, cb); zn[t] = gate * (acc[i] * invn + bias * zs[t]); }
        }
        if (NW == 1) { LDS_WAIT(); asm volatile("" ::: "memory"); } else __syncthreads();
        for (int t = tl; t < L; t += NT) zs[t] = zn[t];
        if (NW == 1) { LDS_WAIT(); asm volatile("" ::: "memory"); } else __syncthreads();
    }
    float* zt = (float*)(a.ws + WS_ZT) + (size_t)c * T + row0;
    for (int t = tl; t < L; t += NT) zt[t] = zs[t];
    if (NW == 1) { LDS_WAIT(); asm volatile("" ::: "memory"); } else __syncthreads();
}
__device__ __forceinline__ void hyena_phase(const Args& a, Frame& F, int ei) {
    {   LAS float* zs = (LAS float*)(F.lds + RING_OFF); LAS float* zn = zs + NS_L; LAS float* ks = zn + NS_L;
        for (int it = F.vcu; it < 2 * 1024; it += F.G) hyena_item<8>(a, ei, NP_B + (it >> 10), it & 1023, zs, ks, zn, F.tid); }
    __syncthreads();
    {   LAS float* zs = (LAS float*)(F.lds + RING_OFF + F.wave * 16384); LAS float* zn = zs + NP_L; LAS float* ks = zn + NP_L;
        for (int it = F.gw; it < 32 * 1024; it += F.NGW) hyena_item<1>(a, ei, it >> 10, it & 1023, zs, ks, zn, F.lane); }
    __syncthreads();
}
__device__ __forceinline__ void hyena_transpose(const Args& a, Frame& F) {
    LAS float* scr = (LAS float*)(F.lds + RING_OFF + F.wave * 16384);
    const float* W = (const float*)(a.ws + WS_ZT); bf16* O = (bf16*)(a.ws + WS_MIX) + 1024;
    constexpr int NIT = (1024 / 64) * (T / 32);
    for (int it = F.gw; it < NIT; it += F.NGW) {
        const int nblk = T / 32, kb = it / nblk, nb = it % nblk, k0 = 64 * kb, n0 = 32 * nb;
#pragma unroll 8
        for (int i = 0; i < 32; ++i) { const int kk = 2 * i + (F.lane >> 5); scr[kk * 33 + (F.lane & 31)] = W[(size_t)(k0 + kk) * T + n0 + (F.lane & 31)]; }
        LDS_WAIT(); asm volatile("" ::: "memory");
        const int c = F.lane & 7;
#pragma unroll
        for (int j = 0; j < 4; ++j) { const int n = (F.lane >> 3) + 8 * j; const LAS float* s = scr + (8 * c) * 33 + n;
            v4u o; o.x = pk2(s[0 * 33], s[1 * 33]); o.y = pk2(s[2 * 33], s[3 * 33]); o.z = pk2(s[4 * 33], s[5 * 33]); o.w = pk2(s[6 * 33], s[7 * 33]);
            *(GAS v4u*)(O + (size_t)(n0 + n) * DM + k0 + 8 * c) = o; }
        LDS_WAIT(); asm volatile("" ::: "memory");
    }
}
__device__ __forceinline__ void rg_gates(const Args& a, Frame& F, int oi) {
    const float* P = (const float*)(a.ws + WS_PROJ); float* AB = (float*)(a.ws + WS_AB);
    LAS float* xs = (LAS float*)(F.lds + RING_OFF + F.wave * 16384);
    for (int it = F.gw; it < (T / 64) * RG_NB; it += F.NGW) {
        const int nb = it & 15, tt = it >> 4, row0 = tt * 64, ch = nb * 64 + F.lane;
        const int sq0 = row0 < TP ? 0 : TP, L = row0 < TP ? NP_L : NS_L, tseq0 = (row0 - sq0) & (L - 1);
        {   const float* cw = a.in[I_RGCW] + (size_t)oi * 4 * 1024; const float w0 = cw[ch], w1 = cw[1024 + ch], w2 = cw[2048 + ch], w3 = cw[3072 + ch], cb = a.in[I_RGCB][oi * 1024 + ch];
            for (int k = 0; k < 64; ++k) { const int t = tseq0 + k; const float* p = P + (size_t)(row0 + k) * ODD_IN + ch;
                const float xm2 = t >= 2 ? p[-2 * ODD_IN] : 0.f, xm1 = t >= 1 ? p[-ODD_IN] : 0.f, x0 = p[0], xp1 = t < L - 1 ? p[ODD_IN] : 0.f;
                xs[k * 64 + F.lane] = cb + w0 * xm2 + w1 * xm1 + w2 * x0 + w3 * xp1; } }
        LDS_WAIT(); asm volatile("" ::: "memory");
        for (int d = 0; d < 2; ++d) {
            float wa[64], wi[64];
            const float* pa = a.in[I_RGWA] + ((size_t)((oi * 2 + d) * RG_NB + nb)) * 4096 + F.lane; const float* pi = a.in[I_RGWI] + ((size_t)((oi * 2 + d) * RG_NB + nb)) * 4096 + F.lane;
#pragma unroll
            for (int c = 0; c < 64; ++c) { wa[c] = pa[c * 64]; wi[c] = pi[c * 64]; }
            const float ba = a.in[I_RGBA][(oi * 2 + d) * 1024 + ch], bi = a.in[I_RGBI][(oi * 2 + d) * 1024 + ch];
            const float lam = a.in[I_RGLAM][(oi * 2 + d) * 1024 + ch], sp = log1pf(expf(-lam));
            for (int k = 0; k < 64; ++k) {
                float sa = ba, si = bi;
#pragma unroll
                for (int c4 = 0; c4 < 16; ++c4) { const f32x4 x = ((const LAS f32x4*)(xs + k * 64))[c4];
                    sa += x.x * wa[4 * c4] + x.y * wa[4 * c4 + 1] + x.z * wa[4 * c4 + 2] + x.w * wa[4 * c4 + 3];
                    si += x.x * wi[4 * c4] + x.y * wi[4 * c4 + 1] + x.z * wi[4 * c4 + 2] + x.w * wi[4 * c4 + 3]; }
                const float r = sigmoidf_(sa), ig = sigmoidf_(si);
                const float loga = -8.0f * r * sp, av = expf(loga), bv = sqrtf(-expm1f(2.0f * loga)) * (ig * xs[k * 64 + F.lane]);
                float* o = AB + ((size_t)(row0 + k) * 4 + d * 2) * 1024 + ch; o[0] = av; o[1024] = bv;
            }
        }
        LDS_WAIT(); asm volatile("" ::: "memory");
    }
}
__device__ __forceinline__ void rg_pass1(const Args& a, Frame& F) {
    const float* AB = (const float*)(a.ws + WS_AB); float* RGS = (float*)(a.ws + WS_RGS);
    for (int it = F.gw; it < 256 * RG_NB * 2; it += F.NGW) {
        const int d = it & 1, nb = (it >> 1) & 15, ck = it >> 5, ch = nb * 64 + F.lane, row0 = ck * 64;
        float A = 1.f, h = 0.f;
        for (int k = 0; k < 64; ++k) { const int row = row0 + (d == 0 ? k : 63 - k); const float* p = AB + ((size_t)row * 4 + d * 2) * 1024 + ch;
            const float av = p[0], bv = p[1024]; A *= av; h = av * h + bv; }
        float* o = RGS + ((size_t)(ck * 2 + d) * 2) * 1024 + ch; o[0] = A; o[1024] = h;
    }
}
__device__ __forceinline__ void rg_pass2(const Args& a, Frame& F, int oi) {
    const float* P = (const float*)(a.ws + WS_PROJ); const float* AB = (const float*)(a.ws + WS_AB); const float* RGS = (const float*)(a.ws + WS_RGS);
    bf16* MIX = (bf16*)(a.ws + WS_MIX);
    LAS float* hf = (LAS float*)(F.lds + RING_OFF + F.wave * 16384);
    for (int it = F.gw; it < 256 * RG_NB; it += F.NGW) {
        const int nb = it & 15, ck = it >> 4, ch = nb * 64 + F.lane, row0 = ck * 64;
        int cfirst, clast, sb = -1, pb = -1;
        if (ck < 128) { pb = ck >> 2; cfirst = pb * 4; clast = cfirst + 3; } else { sb = (ck - 128) >> 6; cfirst = 128 + sb * 64; clast = cfirst + 63; }
        float h = (sb >= 0) ? a.in[I_SRG][((size_t)(sb * 2 + oi) * 2 + 0) * 1024 + ch] : 0.f;
        for (int c = cfirst; c < ck; ++c) { const float* s = RGS + ((size_t)(c * 2 + 0) * 2) * 1024 + ch; h = s[0] * h + s[1024]; }
        for (int k = 0; k < 64; ++k) { const float* p = AB + ((size_t)(row0 + k) * 4 + 0) * 1024 + ch; h = p[0] * h + p[1024]; hf[k * 64 + F.lane] = h; }
        if (pb >= 0 && ck == clast) a.out[OUT_RG + ((size_t)(pb * 2 + oi) * 2 + 0) * 1024 + ch] = h;
        h = (sb >= 0) ? a.in[I_SRG][((size_t)(sb * 2 + oi) * 2 + 1) * 1024 + ch] : 0.f;
        for (int c = clast; c > ck; --c) { const float* s = RGS + ((size_t)(c * 2 + 1) * 2) * 1024 + ch; h = s[0] * h + s[1024]; }
        for (int k = 63; k >= 0; --k) { const size_t row = (size_t)(row0 + k); const float* p = AB + (row * 4 + 2) * 1024 + ch; h = p[0] * h + p[1024];
            const float y = (hf[k * 64 + F.lane] + h) * gelu_tanh(P[row * ODD_IN + 1024 + ch]);
            MIX[row * DM + ch] = (bf16)f2bf(y); }
        if (pb >= 0 && ck == cfirst) a.out[OUT_RG + ((size_t)(pb * 2 + oi) * 2 + 1) * 1024 + ch] = h;
        LDS_WAIT(); asm volatile("" ::: "memory");
    }
}

__device__ __forceinline__ void qk_norm(const Args& a, Frame& F, int oi) {
    const float* P = (const float*)(a.ws + WS_PROJ); float* QN = (float*)(a.ws + WS_QN); float* KN = (float*)(a.ws + WS_KN);
    const float gq = a.in[I_NAQN][oi * 64 + F.lane], gk = a.in[I_NAKN][oi * 64 + F.lane];
    for (int row = F.gw; row < T; row += F.NGW) {
        const float* p = P + (size_t)row * ODD_IN;
        for (int h = 0; h < NA_H; ++h) {
            const float q = p[2048 + h * 64 + F.lane], k = p[3072 + h * 64 + F.lane];
            const float rq = 1.0f / sqrtf(wave_sum(q * q) * (1.0f / 64.0f) + EPS), rk = 1.0f / sqrtf(wave_sum(k * k) * (1.0f / 64.0f) + EPS);
            const float qn = q * rq * gq, kn = k * rk * gk;
            QN[(size_t)row * 1024 + h * 64 + F.lane] = qn; KN[(size_t)row * 1024 + h * 64 + F.lane] = kn;
            if (row < TP) { const int b = row >> 8, t = row & 255; const size_t o = ((size_t)((b * 2 + oi) * NP_L + t)) * 1024 + h * 64 + F.lane;
                a.out[OUT_NAK + o] = kn; a.out[OUT_NAV + o] = p[4096 + h * 64 + F.lane]; }
        }
    }
}
struct AttnAcc { float m, l; float o[32]; };
__device__ __forceinline__ void attn_init(AttnAcc& A) { A.m = -1e30f; A.l = 0.f;
#pragma unroll
    for (int d = 0; d < 32; ++d) A.o[d] = 0.f; }
template <class VP>
__device__ __forceinline__ void attn_step2(AttnAcc& A, const float (&s)[2], VP v0, VP v1) {
    const float mn = fmaxf(A.m, fmaxf(s[0], s[1]));
    const float sc = __expf(A.m - mn), p0 = __expf(s[0] - mn), p1 = __expf(s[1] - mn);
    A.m = mn; A.l = A.l * sc + (p0 + p1);
#pragma unroll
    for (int d4 = 0; d4 < 8; ++d4) { const f32x4 a0 = v0[d4], a1 = v1[d4];
        A.o[4 * d4 + 0] = A.o[4 * d4 + 0] * sc + p0 * a0.x + p1 * a1.x;
        A.o[4 * d4 + 1] = A.o[4 * d4 + 1] * sc + p0 * a0.y + p1 * a1.y;
        A.o[4 * d4 + 2] = A.o[4 * d4 + 2] * sc + p0 * a0.z + p1 * a1.z;
        A.o[4 * d4 + 3] = A.o[4 * d4 + 3] * sc + p0 * a0.w + p1 * a1.w; }
}
template <class KP>
__device__ __forceinline__ float attn_dot(const float (&q)[32], KP k) {
    float s0 = 0.f, s1 = 0.f;
#pragma unroll
    for (int d4 = 0; d4 < 8; d4 += 2) { const f32x4 x = k[d4], y = k[d4 + 1];
        s0 += q[4 * d4] * x.x + q[4 * d4 + 1] * x.y + q[4 * d4 + 2] * x.z + q[4 * d4 + 3] * x.w;
        s1 += q[4 * d4 + 4] * y.x + q[4 * d4 + 5] * y.y + q[4 * d4 + 6] * y.z + q[4 * d4 + 7] * y.w; }
    const float s = s0 + s1;
    return s + __shfl_xor(s, 1);
}
__device__ __forceinline__ void attn_store(const AttnAcc& A, bf16* o) {
    const float il = 1.0f / A.l;
#pragma unroll
    for (int d8 = 0; d8 < 4; ++d8) { v4u w; w.x = pk2(A.o[8 * d8] * il, A.o[8 * d8 + 1] * il); w.y = pk2(A.o[8 * d8 + 2] * il, A.o[8 * d8 + 3] * il);
        w.z = pk2(A.o[8 * d8 + 4] * il, A.o[8 * d8 + 5] * il); w.w = pk2(A.o[8 * d8 + 6] * il, A.o[8 * d8 + 7] * il); *(GAS v4u*)(o + 8 * d8) = w; }
}
__device__ __forceinline__ void attn_ctx(const Args& a, Frame& F) {
    const float* P = (const float*)(a.ws + WS_PROJ); const float* QN = (const float*)(a.ws + WS_QN); const float* KN = (const float*)(a.ws + WS_KN);
    bf16* MIX = (bf16*)(a.ws + WS_MIX);
    LAS float* Ks = (LAS float*)(F.lds + RING_OFF);
    LAS float* Vs = Ks + 64 * 64;
    const int dh = F.tid & 1, qi = F.tid >> 1;
    for (int it = F.vcu; it < NP_B * NA_H; it += F.G) {
        const int b = it >> 4, h = it & 15, row = b * NP_L + qi;
        float q[32];
#pragma unroll
        for (int d4 = 0; d4 < 8; ++d4) { const f32x4 x = *(const GAS f32x4*)(QN + (size_t)row * 1024 + h * 64 + dh * 32 + 4 * d4); q[4 * d4] = x.x * 0.125f; q[4 * d4 + 1] = x.y * 0.125f; q[4 * d4 + 2] = x.z * 0.125f; q[4 * d4 + 3] = x.w * 0.125f; }
        AttnAcc A; attn_init(A);
        for (int kt = 0; kt < 4; ++kt) {
            __syncthreads();
            for (int i = F.tid; i < 64 * 16; i += NTHR) { const int d4 = i & 15, j = i >> 4; const size_t kr = (size_t)(b * NP_L + kt * 64 + j);
                ((LAS f32x4*)Ks)[i] = *(const GAS f32x4*)(KN + kr * 1024 + h * 64 + 4 * d4);
                ((LAS f32x4*)Vs)[i] = *(const GAS f32x4*)(P + kr * ODD_IN + 4096 + h * 64 + 4 * d4); }
            __syncthreads();
            const LAS f32x4* kb = (const LAS f32x4*)Ks + dh * 8; const LAS f32x4* vb = (const LAS f32x4*)Vs + dh * 8;
            for (int j = 0; j < 64; j += 2) {
                float s[2];
#pragma unroll
                for (int e = 0; e < 2; ++e) s[e] = attn_dot(q, kb + (j + e) * 16);
                attn_step2(A, s, vb + j * 16, vb + (j + 1) * 16);
            }
        }
        attn_store(A, MIX + (size_t)row * DM + 1024 + h * 64 + dh * 32);
    }
    __syncthreads();
}
__device__ __forceinline__ void attn_na(const Args& a, Frame& F, int oi) {
    const float* P = (const float*)(a.ws + WS_PROJ); const float* QN = (const float*)(a.ws + WS_QN); const float* KN = (const float*)(a.ws + WS_KN);
    bf16* MIX = (bf16*)(a.ws + WS_MIX);
    LAS float* Ks = (LAS float*)(F.lds + RING_OFF);
    LAS float* Vs = Ks + 128 * 64;
    const int dh = F.tid & 1;
    for (int it = F.vcu; it < NS_B * NA_H * 16; it += F.G) {
        const int rg = it & 15, h = (it >> 4) & 15, b = it >> 8;
        const int r = rg * 4 + (F.tid >> 7), qc = (F.tid >> 1) & 63, row = TP + b * NS_L + r * GRID_W + qc;
        float q[32];
#pragma unroll
        for (int d4 = 0; d4 < 8; ++d4) { const f32x4 x = *(const GAS f32x4*)(QN + (size_t)row * 1024 + h * 64 + dh * 32 + 4 * d4); q[4 * d4] = x.x * 0.125f; q[4 * d4 + 1] = x.y * 0.125f; q[4 * d4 + 2] = x.z * 0.125f; q[4 * d4 + 3] = x.w * 0.125f; }
        AttnAcc A; attn_init(A);
        const int rs = min(max(r - WIN_R / 2, 0), GRID_R - WIN_R), cs = min(max(qc - WIN_C / 2, 0), GRID_W - WIN_C);
        const float* rpb = a.in[I_NARPB] + (size_t)(oi * NA_H + h) * (2 * WIN_R - 1) * (2 * WIN_C - 1);
        for (int kr = 0; kr < WIN_R; ++kr) {
            const int krow = rs + kr; const float* brow = rpb + (krow - r + WIN_R - 1) * (2 * WIN_C - 1) + (cs - qc + WIN_C - 1);
            const size_t base = (size_t)(TP + b * NS_L + krow * GRID_W + cs);
            for (int kc = 0; kc < WIN_C; kc += 2) {
                float s[2];
#pragma unroll
                for (int e = 0; e < 2; ++e) s[e] = attn_dot(q, (const GAS f32x4*)(KN + (base + kc + e) * 1024 + h * 64 + dh * 32)) + brow[kc + e];
                attn_step2(A, s, (const GAS f32x4*)(P + (base + kc) * ODD_IN + 4096 + h * 64 + dh * 32), (const GAS f32x4*)(P + (base + kc + 1) * ODD_IN + 4096 + h * 64 + dh * 32));
            }
        }
        const float* CK = a.in[I_CK] + ((size_t)(b * 2 + oi) * PAST) * 1024 + h * 64; const float* CV = a.in[I_CV] + ((size_t)(b * 2 + oi) * PAST) * 1024 + h * 64;
        for (int kt = 0; kt < PAST / 128; ++kt) {
            __syncthreads();
            for (int i = F.tid; i < 128 * 16; i += NTHR) { const int d4 = i & 15, j = i >> 4; const size_t ko = (size_t)(kt * 128 + j) * 1024 + 4 * d4;
                ((LAS f32x4*)Ks)[i] = *(const GAS f32x4*)(CK + ko); ((LAS f32x4*)Vs)[i] = *(const GAS f32x4*)(CV + ko); }
            __syncthreads();
            const LAS f32x4* kb = (const LAS f32x4*)Ks + dh * 8; const LAS f32x4* vb = (const LAS f32x4*)Vs + dh * 8;
            for (int j = 0; j < 128; j += 2) {
                float s[2];
#pragma unroll
                for (int e = 0; e < 2; ++e) s[e] = attn_dot(q, kb + (j + e) * 16);
                attn_step2(A, s, vb + j * 16, vb + (j + 1) * 16);
            }
        }
        attn_store(A, MIX + (size_t)row * DM + 1024 + h * 64 + dh * 32);
    }
    __syncthreads();
}
#ifndef EN
#define EN 0xFFFF
#endif
#ifndef EN_GEMM
#define EN_GEMM 63
#endif
constexpr int NPHASES = 2 + DEPTH * 12;
typedef const __attribute__((address_space(4))) Args* KArgsPtr;
__device__ __forceinline__ Frame mkframe(unsigned char* lds_raw) {
    Frame F;
    int tid = threadIdx.x, bx = blockIdx.x, G = gridDim.x;
    asm volatile("" : "+v"(tid), "+s"(bx), "+s"(G));
    F.lds = (LAS unsigned char*)lds_raw;
    F.tid = tid; F.lane = tid & 63; F.wave = __builtin_amdgcn_readfirstlane(tid >> 6);
    F.G = G; F.vcu = (G % 8 == 0) ? (bx % 8) * (G / 8) + bx / 8 : bx;
    F.gw = F.vcu * NWAVES + F.wave; F.NGW = G * NWAVES;
    return F;
}
__global__ void __launch_bounds__(NTHR, 2) fwd_kernel(Args args_unused) {
    extern __shared__ __attribute__((aligned(16))) unsigned char lds_raw[];
    {   LAS unsigned* z = (LAS unsigned*)((LAS unsigned char*)lds_raw + LDSCTL_OFF);
        for (int u = threadIdx.x; u < (LDS_BYTES - LDSCTL_OFF) / 4; u += NTHR) z[u] = 0u; }
    __syncthreads();
    KArgsPtr kp0 = (KArgsPtr)__builtin_amdgcn_kernarg_segment_ptr();
    XcdBarrier bar = xcd_barrier_post((unsigned*)(kp0->ws + WS_CTL) + CW_BAR, (volatile LAS unsigned*)((LAS unsigned char*)lds_raw + MISC_OFF) + 8);
    const int lo = kp0->ph_lo, hi = kp0->ph_hi;
    int pc = 0;
#define PH_ON() (pc >= lo && pc < hi)
#define PH_END() do { if (pc >= lo && pc + 1 < hi) xcd_barrier(bar); ++pc; } while (0)
#define PH_ARGS() KArgsPtr kp = (KArgsPtr)__builtin_amdgcn_kernarg_segment_ptr(); asm volatile("" : "+s"(kp)); const Args args = *(const Args*)kp; Frame F = mkframe(lds_raw); \
    unsigned char* ws = args.ws; float* X = args.out; LAS unsigned char* ring = F.lds + RING_OFF; (void)ws; (void)X; (void)ring; (void)F

    if (PH_ON()) { PH_ARGS();
#if EN & 1
        p0_copy_x(args, F); p0_adaln(args, F); p0_s5params(args, F);
#endif
#if EN & 2
        p0_hyena_filters(args, F);
#endif
#if EN & 4
        p0_weights(args, F);
#endif
    }
    PH_END();
    if (PH_ON()) { PH_ARGS(); p0b_adaln_final(args, F); p0b_hyena_norm(args, F); }
    PH_END();

#pragma clang loop unroll(disable)
    for (int li = 0; li < DEPTH; ++li) {
#pragma clang loop unroll(disable)
        for (int half = 0; half < 2; ++half) {
#define MODP() ((const float*)(ws + WS_MOD) + (size_t)li * 3 * NMOD * DM)
#define NGP() (args.in[I_NG] + (size_t)li * 3 * DM)
            if (PH_ON()) { PH_ARGS(); phase_norm(args, F, NGP() + (half ? 2 : 0) * DM, MODP() + (half ? 6 : 0) * DM, MODP() + (half ? 7 : 1) * DM); }
            PH_END();
            if (PH_ON()) { PH_ARGS(); pg8::Gemm g{(const bf16*)(ws + WS_H), (const bf16*)(ws + WS_WGU) + (size_t)(li * 2 + half) * 2 * DFF * DM, T, 2 * DFF, DM};
                pg8::StaticOrder S; S.init(T, 2 * DFF, F.G, (int)blockIdx.x); pg8::EpiSwiGLU E{(bf16*)(ws + WS_A1), DFF};
                if (EN_GEMM & 1) pg8::gemm_phase<pg8::EpiSwiGLU, pg8::StaticOrder, PG8_ALIGN, PG8_SP2>(ring, g, S, E); }
            PH_END();
            if (PH_ON()) { PH_ARGS(); pg8::Gemm g{(const bf16*)(ws + WS_A1), (const bf16*)(ws + WS_WD) + (size_t)(li * 2 + half) * DM * DFF, T, DM, DFF};
                pg8::StaticOrder S; S.init(T, DM, F.G, (int)blockIdx.x); pg8::EpiResid E{X, DM, MODP() + (half ? 8 : 2) * DM, NMOD * DM, 0.5f};
                if (EN_GEMM & 2) pg8::gemm_phase<pg8::EpiResid, pg8::StaticOrder, PG8_ALIGN, PG8_SP2>(ring, g, S, E); }
            PH_END();
            if (half == 0) {
                if (PH_ON()) { PH_ARGS(); phase_norm(args, F, NGP() + DM, MODP() + 3 * DM, MODP() + 4 * DM); }
                PH_END();
                if ((li & 1) == 0) {
                    const int ei = li >> 1;
                    if (PH_ON()) { PH_ARGS();
                        { pg8::Gemm g{(const bf16*)(ws + WS_H), (const bf16*)(ws + WS_WINE) + (size_t)ei * EVEN_IN * DM, T, HALFW, DM};
                          pg8::StaticOrder S; S.init(T, HALFW, F.G, (int)blockIdx.x); pg8::EpiF32 E{(float*)(ws + WS_PROJ), HALFW};
                          if (EN_GEMM & 4) pg8::gemm_phase<pg8::EpiF32, pg8::StaticOrder, PG8_ALIGN, PG8_SP2>(ring, g, S, E); }
                        { pg8::Gemm g{(const bf16*)(ws + WS_WINE) + (size_t)ei * EVEN_IN * DM + (size_t)HALFW * DM, (const bf16*)(ws + WS_H), 3 * HALFW, T, DM};
                          pg8::StaticOrder S; S.init(3 * HALFW, T, F.G, (int)blockIdx.x); pg8::EpiF32 E{(float*)(ws + WS_PROJ + PROJT_OFF), T};
                          if (EN_GEMM & 4) pg8::gemm_phase<pg8::EpiF32, pg8::StaticOrder, PG8_ALIGN, PG8_SP2>(ring, g, S, E); }
                    }
                    PH_END();
                    if (PH_ON()) { PH_ARGS();
#if EN & 8
                        s5_pass1(args, F, ei); __syncthreads();
#endif
#if EN & 16
                        hyena_phase(args, F, ei);
#endif
                    }
                    PH_END();
                    if (PH_ON()) { PH_ARGS();
#if EN & 32
                        s5_pass2(args, F, ei); __syncthreads();
#endif
#if EN & 64
                        hyena_transpose(args, F); __syncthreads();
#endif
                    }
                    PH_END();
                    if (PH_ON()) { PH_ARGS(); pg8::Gemm g{(const bf16*)(ws + WS_Z), (const bf16*)(ws + WS_WGLU) + (size_t)ei * HALFW * HALFW, T, HALFW, HALFW};
                        pg8::StaticOrder S; S.init(T, HALFW, F.G, (int)blockIdx.x); pg8::EpiGLU E{(const bf16*)(ws + WS_Z), HALFW, args.in[I_S5GLUB] + ei * HALFW, (bf16*)(ws + WS_MIX), DM};
                        if (EN_GEMM & 8) pg8::gemm_phase<pg8::EpiGLU, pg8::StaticOrder, PG8_ALIGN, PG8_SP2>(ring, g, S, E); }
                    PH_END();
                } else {
                    const int oi = li >> 1;
                    if (PH_ON()) { PH_ARGS(); pg8::Gemm g{(const bf16*)(ws + WS_H), (const bf16*)(ws + WS_WINO) + (size_t)oi * ODD_IN * DM, T, ODD_IN, DM};
                        pg8::StaticOrder S; S.init(T, ODD_IN, F.G, (int)blockIdx.x); pg8::EpiF32 E{(float*)(ws + WS_PROJ), ODD_IN};
                        if (EN_GEMM & 16) pg8::gemm_phase<pg8::EpiF32, pg8::StaticOrder, PG8_ALIGN, PG8_SP2>(ring, g, S, E); }
                    PH_END();
                    if (PH_ON()) { PH_ARGS();
#if EN & 128
                        rg_gates(args, F, oi); __syncthreads();
#endif
#if EN & 256
                        qk_norm(args, F, oi);
#endif
                    }
                    PH_END();
                    if (PH_ON()) { PH_ARGS();
#if EN & 512
                        rg_pass1(args, F); __syncthreads();
#endif
#if EN & 1024
                        attn_ctx(args, F);
#endif
#if EN & 2048
                        attn_na(args, F, oi);
#endif
                    }
                    PH_END();
                    if (PH_ON()) { PH_ARGS();
#if EN & 4096
                        rg_pass2(args, F, oi); __syncthreads();
#endif
                    }
                    PH_END();
                }
                if (PH_ON()) { PH_ARGS(); pg8::Gemm g{(const bf16*)(ws + WS_MIX), (const bf16*)(ws + WS_WOUT) + (size_t)li * DM * DM, T, DM, DM};
                    pg8::StaticOrder S; S.init(T, DM, F.G, (int)blockIdx.x); pg8::EpiResid E{X, DM, MODP() + 5 * DM, NMOD * DM, 1.0f};
                    if (EN_GEMM & 32) pg8::gemm_phase<pg8::EpiResid, pg8::StaticOrder, PG8_ALIGN, PG8_SP2>(ring, g, S, E); }
                PH_END();
            }
        }
    }
#undef PH_ON
#undef PH_END
}

extern "C" void kernel_launch(void* const* d_in, const int* in_sizes, int n_in, void* d_out, int out_size, void* d_ws, size_t ws_size, hipStream_t stream) {
    static int grid = 0;
    if (grid == 0) {
        if (n_in != N_IN || (size_t)out_size != OUT_END || ws_size < WS_END) { fprintf(stderr, "kernel_launch: unexpected shapes: n_in %d out %d ws %zu (need %zu)\n", n_in, out_size, ws_size, (size_t)WS_END); grid = -1; return; }
        int dev = 0, cus = 0, per_cu = 0;
        if (hipGetDevice(&dev) != hipSuccess || hipDeviceGetAttribute(&cus, hipDeviceAttributeMultiprocessorCount, dev) != hipSuccess) { grid = -1; return; }
        if (hipFuncSetAttribute((const void*)fwd_kernel, hipFuncAttributeMaxDynamicSharedMemorySize, LDS_BYTES) != hipSuccess) { fprintf(stderr, "kernel_launch: hipFuncSetAttribute failed\n"); grid = -1; return; }
        if (hipOccupancyMaxActiveBlocksPerMultiprocessor(&per_cu, (const void*)fwd_kernel, NTHR, LDS_BYTES) != hipSuccess || per_cu < 1) fprintf(stderr, "kernel_launch: occupancy query says %d\n", per_cu);
        (void)hipGetLastError();
        grid = cus;
    }
    if (grid < 0) return;
    (void)hipMemsetAsync((char*)d_ws + WS_CTL, 0, CTL_ZERO_BYTES, stream);
    Args a{};
    for (int i = 0; i < N_IN; ++i) a.in[i] = (const float*)d_in[i];
    a.out = (float*)d_out; a.ws = (unsigned char*)d_ws;
#if MK_PER_PHASE
    for (int ph = 0; ph < NPHASES; ++ph) { a.ph_lo = ph; a.ph_hi = ph + 1; hipLaunchKernelGGL(fwd_kernel, dim3(grid), dim3(NTHR), LDS_BYTES, stream, a); }
#else
    a.ph_lo = 0; a.ph_hi = NPHASES;
    hipLaunchKernelGGL(fwd_kernel, dim3(grid), dim3(NTHR), LDS_BYTES, stream, a);
#endif
}
```

```cpp
#include <hip/hip_runtime.h>
#include <cstdio>
#include <cstdint>
namespace pg8 {
#define PG8_LAS __attribute__((address_space(3)))
typedef unsigned short bf16_t;
typedef short bf16x8 __attribute__((ext_vector_type(8)));
typedef float f32x4 __attribute__((ext_vector_type(4)));
typedef unsigned u32x4 __attribute__((ext_vector_type(4)));
constexpr int BM = 256, BK = 64, HALF = 128, HTB = HALF * BK * 2  , STAGE_BYTES = 8 * HTB, NXCD = 8, WGM = 8;

__host__ __device__ __forceinline__ int lds_byte(int r, int c) { const int st = (r >> 4) * 2 + (c >> 5), rr = r & 15, cc = c & 31, ob = rr * 64 + cc * 2; return st * 1024 + (ob ^ (((ob >> 9) & 1) << 5)); }
__host__ __device__ __forceinline__ void stage_rc(int b, int& R, int& C) { const int st = b / 1024, sb = b % 1024, swz = sb ^ (((sb >> 9) & 1) << 5); R = (st >> 1) * 16 + swz / 64; C = (st & 1) * 32 + (swz % 64) / 2; }
__host__ __device__ __forceinline__ int perm32(int rho) { const int n = rho >> 4, i = rho & 15; return 8 * (i >> 2) + 4 * n + (i & 3); }

struct Unit { int pm, pn; };
struct Gemm { const bf16_t* A; const bf16_t* Bt; int M, N, K; };

struct StaticOrder {
    int nM, nN, nwg, G, c;
    __host__ __device__ void init(int M, int N, int G_, int c_) { nM = M / BM; nN = N / BM; nwg = nM * nN; G = G_; c = c_; }
    __host__ __device__ bool next(int i, Unit& u) const {
        const long L = (long)i * G + c; if (L >= nwg) return false;
        int wgid = (int)L; { const int q = nwg / NXCD, r = nwg % NXCD, xcd = wgid % NXCD, off = wgid / NXCD; wgid = (xcd < r ? xcd * (q + 1) : r * (q + 1) + (xcd - r) * q) + off; }
        const int nig = WGM * nN, gid = wgid / nig, fm = gid * WGM, gsz = (nM - fm) < WGM ? (nM - fm) : WGM;
        u.pm = fm + ((wgid % nig) % gsz); u.pn = (wgid % nig) / gsz; return true;
    }
    __device__ __forceinline__ void a_ready(const Unit&) const {}
    __device__ __forceinline__ void done(const Unit&) const {}
};

typedef __bf16 bf2_t __attribute__((ext_vector_type(2)));
typedef float f32x2_t __attribute__((ext_vector_type(2)));
__device__ __forceinline__ unsigned cvt_pk_bf16(float lo, float hi) { const f32x2_t v = {lo, hi}; const bf2_t b = __builtin_convertvector(v, bf2_t); return __builtin_bit_cast(unsigned, b); }
__device__ __forceinline__ float fsigmoid(float x) { return __builtin_amdgcn_rcpf(1.0f + __expf(-x)); }

struct EpiF32 {
    static constexpr bool PERM = false, AFTER_DRAIN = false;
    float* C; int ldc;
    __device__ __forceinline__ void operator()(const f32x4 (&acc)[2][2][4][2], const Unit& u, int wr, int wc, int fr, int fq) const {
        const int row0 = u.pm * BM + wr * 64 + fr, col0 = u.pn * BM + wc * 32 + 4 * fq;
#pragma unroll
        for (int ai = 0; ai < 2; ++ai)
#pragma unroll
            for (int m = 0; m < 4; ++m) { float* rowp = C + (size_t)(row0 + ai * HALF + m * 16) * ldc + col0;
#pragma unroll
                for (int bj = 0; bj < 2; ++bj)
#pragma unroll
                    for (int n = 0; n < 2; ++n) *(f32x4*)(rowp + bj * HALF + n * 16) = acc[ai][bj][m][n]; }
    }
};
struct EpiBf16 {
    static constexpr bool PERM = true, AFTER_DRAIN = false;
    bf16_t* O; int ldc;
    __device__ __forceinline__ void operator()(const f32x4 (&acc)[2][2][4][2], const Unit& u, int wr, int wc, int fr, int fq) const {
        const int row0 = u.pm * BM + wr * 64 + fr, col0 = u.pn * BM + wc * 32 + 8 * fq;
#pragma unroll
        for (int ai = 0; ai < 2; ++ai)
#pragma unroll
            for (int m = 0; m < 4; ++m) { bf16_t* rowp = O + (size_t)(row0 + ai * HALF + m * 16) * ldc + col0;
#pragma unroll
                for (int bj = 0; bj < 2; ++bj) { const f32x4 v0 = acc[ai][bj][m][0], v1 = acc[ai][bj][m][1];
                    u32x4 w; w.x = cvt_pk_bf16(v0[0], v0[1]); w.y = cvt_pk_bf16(v0[2], v0[3]); w.z = cvt_pk_bf16(v1[0], v1[1]); w.w = cvt_pk_bf16(v1[2], v1[3]);
                    *(u32x4*)(rowp + bj * HALF) = w; } }
    }
};
struct EpiSwiGLU {
    static constexpr bool PERM = true, AFTER_DRAIN = false;
    bf16_t* O; int ldc;
    __device__ __forceinline__ void operator()(const f32x4 (&acc)[2][2][4][2], const Unit& u, int wr, int wc, int fr, int fq) const {
        const int row0 = u.pm * BM + wr * 64 + fr, col0 = u.pn * HALF + wc * 32 + 8 * fq;
#pragma unroll
        for (int ai = 0; ai < 2; ++ai)
#pragma unroll
            for (int m = 0; m < 4; ++m) { bf16_t* rowp = O + (size_t)(row0 + ai * HALF + m * 16) * ldc + col0;
                f32x4 r0, r1;
#pragma unroll
                for (int j = 0; j < 4; ++j) { const float g0 = acc[ai][0][m][0][j], g1 = acc[ai][0][m][1][j];
                    r0[j] = g0 * fsigmoid(g0) * acc[ai][1][m][0][j]; r1[j] = g1 * fsigmoid(g1) * acc[ai][1][m][1][j]; }
                u32x4 w; w.x = cvt_pk_bf16(r0[0], r0[1]); w.y = cvt_pk_bf16(r0[2], r0[3]); w.z = cvt_pk_bf16(r1[0], r1[1]); w.w = cvt_pk_bf16(r1[2], r1[3]);
                *(u32x4*)rowp = w; }
    }
};
struct EpiResid {
    static constexpr bool PERM = false, AFTER_DRAIN = false;
    float* X; int ldc; const float* gate; int gstride; float coef;
    __device__ __forceinline__ void operator()(const f32x4 (&acc)[2][2][4][2], const Unit& u, int wr, int wc, int fr, int fq) const {
        const int row0 = u.pm * BM + wr * 64 + fr, col0 = u.pn * BM + wc * 32 + 4 * fq;
        const int cond = u.pm < 32 ? 0 : (u.pm < 48 ? 1 : 2);
        const float* gp = gate + (size_t)cond * gstride + col0;
        f32x4 gv[2][2];
#pragma unroll
        for (int bj = 0; bj < 2; ++bj)
#pragma unroll
            for (int n = 0; n < 2; ++n) gv[bj][n] = *(const f32x4*)(gp + bj * HALF + n * 16) * coef;
#pragma unroll
        for (int ai = 0; ai < 2; ++ai)
#pragma unroll
            for (int m = 0; m < 4; ++m) { float* rowp = X + (size_t)(row0 + ai * HALF + m * 16) * ldc + col0;
#pragma unroll
                for (int bj = 0; bj < 2; ++bj)
#pragma unroll
                    for (int n = 0; n < 2; ++n) { f32x4* p = (f32x4*)(rowp + bj * HALF + n * 16); *p = *p + gv[bj][n] * acc[ai][bj][m][n]; } }
    }
};
struct EpiGLU {
    static constexpr bool PERM = true, AFTER_DRAIN = false;
    const bf16_t* Z; int ldz; const float* bias; bf16_t* O; int ldo;
    __device__ __forceinline__ void operator()(const f32x4 (&acc)[2][2][4][2], const Unit& u, int wr, int wc, int fr, int fq) const {
        const int row0 = u.pm * BM + wr * 64 + fr, col0 = u.pn * BM + wc * 32 + 8 * fq;
        f32x4 bv[2][2];
#pragma unroll
        for (int bj = 0; bj < 2; ++bj)
#pragma unroll
            for (int n = 0; n < 2; ++n) bv[bj][n] = *(const f32x4*)(bias + col0 + bj * HALF + 4 * n);
#pragma unroll
        for (int ai = 0; ai < 2; ++ai)
#pragma unroll
            for (int m = 0; m < 4; ++m) { const size_t row = (size_t)(row0 + ai * HALF + m * 16);
#pragma unroll
                for (int bj = 0; bj < 2; ++bj) { const u32x4 zz = *(const u32x4*)(Z + row * ldz + col0 + bj * HALF);
                    const f32x4 v0 = acc[ai][bj][m][0] + bv[bj][0], v1 = acc[ai][bj][m][1] + bv[bj][1];
                    float zf[8];
#pragma unroll
                    for (int j = 0; j < 4; ++j) { zf[2 * j] = __uint_as_float(zz[j] << 16); zf[2 * j + 1] = __uint_as_float(zz[j] & 0xffff0000u); }
                    float o[8];
#pragma unroll
                    for (int j = 0; j < 4; ++j) { o[j] = zf[j] * fsigmoid(v0[j]); o[4 + j] = zf[4 + j] * fsigmoid(v1[j]); }
                    u32x4 w; w.x = cvt_pk_bf16(o[0], o[1]); w.y = cvt_pk_bf16(o[2], o[3]); w.z = cvt_pk_bf16(o[4], o[5]); w.w = cvt_pk_bf16(o[6], o[7]);
                    *(u32x4*)(O + row * ldo + col0 + bj * HALF) = w; } }
    }
};

struct EpiDelta {
    static constexpr bool PERM = true, AFTER_DRAIN = false;
    bf16_t* D; int ldc; const float* gate; int gstride; float coef;
    __device__ __forceinline__ void operator()(const f32x4 (&acc)[2][2][4][2], const Unit& u, int wr, int wc, int fr, int fq) const {
        const int row0 = u.pm * BM + wr * 64 + fr, col0 = u.pn * BM + wc * 32 + 8 * fq;
        const int cond = u.pm < 32 ? 0 : (u.pm < 48 ? 1 : 2);
        const float* gp = gate + (size_t)cond * gstride + col0;
        f32x4 gv[2][2];
#pragma unroll
        for (int bj = 0; bj < 2; ++bj)
#pragma unroll
            for (int n = 0; n < 2; ++n) gv[bj][n] = *(const f32x4*)(gp + bj * HALF + 4 * n) * coef;
#pragma unroll
        for (int ai = 0; ai < 2; ++ai)
#pragma unroll
            for (int m = 0; m < 4; ++m) { bf16_t* rowp = D + (size_t)(row0 + ai * HALF + m * 16) * ldc + col0;
#pragma unroll
                for (int bj = 0; bj < 2; ++bj) { const f32x4 v0 = acc[ai][bj][m][0] * gv[bj][0], v1 = acc[ai][bj][m][1] * gv[bj][1];
                    u32x4 w; w.x = cvt_pk_bf16(v0[0], v0[1]); w.y = cvt_pk_bf16(v0[2], v0[3]); w.z = cvt_pk_bf16(v1[0], v1[1]); w.w = cvt_pk_bf16(v1[2], v1[3]);
                    *(u32x4*)(rowp + bj * HALF) = w; } }
    }
};

struct EpiFinal {
    static constexpr bool PERM = false, AFTER_DRAIN = false;
    const bf16_t* Xb; float* Out; int ldc; const float* gate; int gstride; float coef;
    __device__ __forceinline__ void operator()(const f32x4 (&acc)[2][2][4][2], const Unit& u, int wr, int wc, int fr, int fq) const {
        const int row0 = u.pm * BM + wr * 64 + fr, col0 = u.pn * BM + wc * 32 + 4 * fq;
        const int cond = u.pm < 32 ? 0 : (u.pm < 48 ? 1 : 2);
        const float* gp = gate + (size_t)cond * gstride + col0;
        f32x4 gv[2][2];
#pragma unroll
        for (int bj = 0; bj < 2; ++bj)
#pragma unroll
            for (int n = 0; n < 2; ++n) gv[bj][n] = *(const f32x4*)(gp + bj * HALF + n * 16) * coef;
#pragma unroll
        for (int ai = 0; ai < 2; ++ai)
#pragma unroll
            for (int m = 0; m < 4; ++m) { const size_t ro = (size_t)(row0 + ai * HALF + m * 16) * ldc + col0;
#pragma unroll
                for (int bj = 0; bj < 2; ++bj)
#pragma unroll
                    for (int n = 0; n < 2; ++n) { const size_t o = ro + bj * HALF + n * 16;
                        const unsigned long long xw = *(const unsigned long long*)(Xb + o); const unsigned lo = (unsigned)xw, hi = (unsigned)(xw >> 32);
                        f32x4 xv; xv[0] = __uint_as_float(lo << 16); xv[1] = __uint_as_float(lo & 0xffff0000u); xv[2] = __uint_as_float(hi << 16); xv[3] = __uint_as_float(hi & 0xffff0000u);
                        *(f32x4*)(Out + o) = xv + gv[bj][n] * acc[ai][bj][m][n]; } }
    }
};

struct EpiXb {
    static constexpr bool PERM = true, AFTER_DRAIN = false;
    bf16_t* Xb; int ldc; const float* gate; int gstride; float coef;
    __device__ __forceinline__ void operator()(const f32x4 (&acc)[2][2][4][2], const Unit& u, int wr, int wc, int fr, int fq) const {
        const int row0 = u.pm * BM + wr * 64 + fr, col0 = u.pn * BM + wc * 32 + 8 * fq;
        const int cond = u.pm < 32 ? 0 : (u.pm < 48 ? 1 : 2);
        const float* gp = gate + (size_t)cond * gstride + col0;
        f32x4 gv[2][2];
#pragma unroll
        for (int bj = 0; bj < 2; ++bj)
#pragma unroll
            for (int n = 0; n < 2; ++n) gv[bj][n] = *(const f32x4*)(gp + bj * HALF + 4 * n) * coef;
#pragma unroll
        for (int ai = 0; ai < 2; ++ai)
#pragma unroll
            for (int m = 0; m < 4; ++m) { bf16_t* rowp = Xb + (size_t)(row0 + ai * HALF + m * 16) * ldc + col0;
#pragma unroll
                for (int bj = 0; bj < 2; ++bj) { const u32x4 x = *(const u32x4*)(rowp + bj * HALF);
                    f32x4 x0, x1; x0[0] = __uint_as_float(x.x << 16); x0[1] = __uint_as_float(x.x & 0xffff0000u); x0[2] = __uint_as_float(x.y << 16); x0[3] = __uint_as_float(x.y & 0xffff0000u);
                    x1[0] = __uint_as_float(x.z << 16); x1[1] = __uint_as_float(x.z & 0xffff0000u); x1[2] = __uint_as_float(x.w << 16); x1[3] = __uint_as_float(x.w & 0xffff0000u);
                    const f32x4 v0 = x0 + acc[ai][bj][m][0] * gv[bj][0], v1 = x1 + acc[ai][bj][m][1] * gv[bj][1];
                    u32x4 w; w.x = cvt_pk_bf16(v0[0], v0[1]); w.y = cvt_pk_bf16(v0[2], v0[3]); w.z = cvt_pk_bf16(v1[0], v1[1]); w.w = cvt_pk_bf16(v1[2], v1[3]);
                    *(u32x4*)(rowp + bj * HALF) = w; } }
    }
};

template <class Epi, class Sched, bool ALIGN_EPI = false, bool SP2 = false>
__device__ __forceinline__ void gemm_phase(PG8_LAS unsigned char* lds, const Gemm g, const Sched& S, const Epi& E) {
    int tid_ = threadIdx.x; asm volatile("" : "+v"(tid_));
    const int tid = tid_, wid = __builtin_amdgcn_readfirstlane(tid >> 6), lane = tid & 63, wr = wid >> 2, wc = wid & 3, fr = lane & 15, fq = lane >> 4;
    const int K = g.K, nt = K / BK;
    unsigned voffA[2], voffB[2];
#pragma unroll
    for (int i = 0; i < 2; ++i) { int R, C; stage_rc(tid * 16 + i * 8192, R, C); const int Rb = Epi::PERM ? ((R & ~31) + perm32(R & 31)) : R;
        voffA[i] = (unsigned)(R * K + C) * 2u; voffB[i] = (unsigned)(Rb * K + C) * 2u; }
    const size_t kstep = (size_t)(BK * 2);
    const size_t hstep = (size_t)HALF * K * 2;
    const size_t tstep = 2 * hstep;
    const unsigned ldsw = (unsigned)wid * 1024u;
    const int aoff = lds_byte(wr * 64 + fr, fq * 8), boff = lds_byte(wc * 32 + fr, fq * 8);
#define PG8_SA(b, h) (((b) * 2 + (h)) * HTB)
#define PG8_SB(b, h) ((4 + (b) * 2 + (h)) * HTB)
#define PG8_STAGE(bufoff, gbase, voff) do { _Pragma("unroll") for (int _i = 0; _i < 2; ++_i) \
        __builtin_amdgcn_global_load_lds((const unsigned*)((const char*)(gbase) + (voff)[_i]), (PG8_LAS unsigned*)(lds + (bufoff) + ldsw + _i * 8192), 16, 0, 0); } while (0)
#define PG8_LDA(dst, b, h) do { _Pragma("unroll") for (int m = 0; m < 4; ++m) _Pragma("unroll") for (int k = 0; k < 2; ++k) dst[m][k] = *(const PG8_LAS bf16x8*)(lds + PG8_SA(b, h) + aoff + m * 2048 + k * 1024); } while (0)
#define PG8_LDB(dst, b, h) do { _Pragma("unroll") for (int n = 0; n < 2; ++n) _Pragma("unroll") for (int k = 0; k < 2; ++k) dst[n][k] = *(const PG8_LAS bf16x8*)(lds + PG8_SB(b, h) + boff + n * 2048 + k * 1024); } while (0)
#define PG8_MMA(ai, bj, At, Bt) do { __builtin_amdgcn_s_setprio(1); _Pragma("unroll") for (int m = 0; m < 4; ++m) _Pragma("unroll") for (int n = 0; n < 2; ++n) _Pragma("unroll") for (int k = 0; k < 2; ++k) \
        acc[ai][bj][m][n] = __builtin_amdgcn_mfma_f32_16x16x32_bf16(Bt[n][k], At[m][k], acc[ai][bj][m][n], 0, 0, 0); __builtin_amdgcn_s_setprio(0); } while (0)
#define PG8_WAIT_V(n) asm volatile("s_waitcnt vmcnt(" #n ")" ::: "memory")
#define PG8_WAIT_L(n) asm volatile("s_waitcnt lgkmcnt(" #n ")" ::: "memory")
#define PG8_BAR __builtin_amdgcn_s_barrier()
#define PG8_SCHED __builtin_amdgcn_sched_barrier(0)
    Unit cur, nxt; int ui = 0;
    if (!S.next(0, cur)) return;
    f32x4 acc[2][2][4][2];
#pragma unroll
    for (int a = 0; a < 2; ++a)
#pragma unroll
        for (int b = 0; b < 2; ++b)
#pragma unroll
            for (int m = 0; m < 4; ++m)
#pragma unroll
                for (int n = 0; n < 2; ++n) acc[a][b][m][n] = (f32x4){0.f, 0.f, 0.f, 0.f};
    bf16x8 At[4][2], B0[2][2], B1[2][2];
    const char* cA = (const char*)g.A + (size_t)cur.pm * tstep; const char* cB = (const char*)g.Bt + (size_t)cur.pn * tstep;
    S.a_ready(cur);
    if constexpr (SP2) {
        PG8_STAGE(PG8_SB(0, 0), cB, voffB); PG8_STAGE(PG8_SB(0, 1), cB + hstep, voffB); PG8_STAGE(PG8_SA(0, 0), cA, voffA); PG8_STAGE(PG8_SA(0, 1), cA + hstep, voffA);
        if (wr == 1) PG8_BAR;
        PG8_WAIT_V(2); PG8_BAR;
        PG8_STAGE(PG8_SB(1, 0), cB + kstep, voffB); PG8_STAGE(PG8_SA(1, 0), cA + kstep, voffA); PG8_STAGE(PG8_SB(1, 1), cB + hstep + kstep, voffB);
        PG8_WAIT_V(6); PG8_BAR;
    } else {
        PG8_STAGE(PG8_SB(0, 0), cB, voffB); PG8_STAGE(PG8_SA(0, 0), cA, voffA); PG8_STAGE(PG8_SB(0, 1), cB + hstep, voffB); PG8_STAGE(PG8_SA(0, 1), cA + hstep, voffA);
        if (wr == 1) PG8_BAR;
        PG8_WAIT_V(4); PG8_BAR;
        PG8_STAGE(PG8_SB(1, 0), cB + kstep, voffB); PG8_STAGE(PG8_SA(1, 0), cA + kstep, voffA); PG8_STAGE(PG8_SB(1, 1), cB + hstep + kstep, voffB);
        PG8_WAIT_V(6); PG8_BAR;
    }
    for (;;) {
        const bool has_next = S.next(ui + 1, nxt);
        const char* nA = has_next ? (const char*)g.A + (size_t)nxt.pm * tstep : cA; const char* nB = has_next ? (const char*)g.Bt + (size_t)nxt.pn * tstep : cB;
        for (int t = 0; t < nt; t += 2) {
            const bool last = (t == nt - 2);
            const char* a1 = cA + (size_t)(t + 1) * kstep;
            const char* a2 = last ? nA : cA + (size_t)(t + 2) * kstep; const char* b2 = last ? nB : cB + (size_t)(t + 2) * kstep;
            const char* a3 = a2 + kstep; const char* b3 = b2 + kstep;
            if (last && has_next) S.a_ready(nxt);
            if constexpr (SP2) {
            PG8_LDB(B0, 0, 0); PG8_LDB(B1, 0, 1); PG8_SCHED; PG8_LDA(At, 0, 0); PG8_STAGE(PG8_SA(1, 1), a1 + hstep, voffA);
            PG8_WAIT_V(8); PG8_WAIT_L(0); PG8_BAR; PG8_MMA(0, 0, At, B0); PG8_MMA(0, 1, At, B1); PG8_BAR; PG8_SCHED;
            PG8_LDA(At, 0, 1); PG8_STAGE(PG8_SB(0, 0), b2, voffB); PG8_STAGE(PG8_SB(0, 1), b2 + hstep, voffB); PG8_STAGE(PG8_SA(0, 0), a2, voffA);
            PG8_WAIT_V(8); PG8_WAIT_L(0); PG8_BAR; PG8_MMA(1, 0, At, B0); PG8_MMA(1, 1, At, B1); PG8_BAR; PG8_SCHED;
            PG8_LDB(B0, 1, 0); PG8_LDB(B1, 1, 1); PG8_SCHED; PG8_LDA(At, 1, 0); PG8_STAGE(PG8_SA(0, 1), a2 + hstep, voffA);
            PG8_WAIT_V(8); PG8_WAIT_L(0); PG8_BAR; PG8_MMA(0, 0, At, B0); PG8_MMA(0, 1, At, B1); PG8_BAR; PG8_SCHED;
            PG8_LDA(At, 1, 1); PG8_STAGE(PG8_SB(1, 0), b3, voffB); PG8_STAGE(PG8_SB(1, 1), b3 + hstep, voffB); PG8_STAGE(PG8_SA(1, 0), a3, voffA);
            PG8_WAIT_V(8); PG8_WAIT_L(0); PG8_BAR; PG8_MMA(1, 0, At, B0); PG8_MMA(1, 1, At, B1); PG8_BAR; PG8_SCHED;
            } else {
            PG8_LDB(B0, 0, 0); PG8_SCHED; PG8_LDA(At, 0, 0); PG8_STAGE(PG8_SA(1, 1), a1 + hstep, voffA);
            PG8_WAIT_L(8); PG8_BAR; PG8_WAIT_L(0); PG8_MMA(0, 0, At, B0); PG8_BAR; PG8_SCHED;
            PG8_LDB(B1, 0, 1); PG8_STAGE(PG8_SB(0, 0), b2, voffB);
            PG8_BAR; PG8_WAIT_L(0); PG8_MMA(0, 1, At, B1); PG8_BAR;
            PG8_LDA(At, 0, 1); PG8_STAGE(PG8_SA(0, 0), a2, voffA);
            PG8_BAR; PG8_WAIT_L(0); PG8_MMA(1, 0, At, B0); PG8_BAR; PG8_SCHED;
            PG8_STAGE(PG8_SB(0, 1), b2 + hstep, voffB);
            PG8_WAIT_V(6); PG8_BAR; PG8_MMA(1, 1, At, B1); PG8_BAR;
            PG8_LDB(B0, 1, 0); PG8_SCHED; PG8_LDA(At, 1, 0); PG8_STAGE(PG8_SA(0, 1), a2 + hstep, voffA);
            PG8_WAIT_L(8); PG8_BAR; PG8_WAIT_L(0); PG8_MMA(0, 0, At, B0); PG8_BAR; PG8_SCHED;
            PG8_LDB(B1, 1, 1); PG8_STAGE(PG8_SB(1, 0), b3, voffB);
            PG8_BAR; PG8_WAIT_L(0); PG8_MMA(0, 1, At, B1); PG8_BAR;
            PG8_LDA(At, 1, 1); PG8_STAGE(PG8_SA(1, 0), a3, voffA);
            PG8_BAR; PG8_WAIT_L(0); PG8_MMA(1, 0, At, B0); PG8_BAR; PG8_SCHED;
            PG8_STAGE(PG8_SB(1, 1), b3 + hstep, voffB);
            PG8_WAIT_V(6); PG8_BAR; PG8_MMA(1, 1, At, B1); PG8_BAR;
            }
        }
        if constexpr (ALIGN_EPI) { if (wr == 0) PG8_BAR; }
        if constexpr (!Epi::AFTER_DRAIN) { E(acc, cur, wr, wc, fr, fq); S.done(cur); }
        if (!has_next) break;
#pragma unroll
        for (int a = 0; a < 2; ++a)
#pragma unroll
            for (int b = 0; b < 2; ++b)
#pragma unroll
                for (int m = 0; m < 4; ++m)
#pragma unroll
                    for (int n = 0; n < 2; ++n) acc[a][b][m][n] = (f32x4){0.f, 0.f, 0.f, 0.f};
        cur = nxt; cA = nA; cB = nB; ++ui;
        if constexpr (ALIGN_EPI) { if (wr == 1) PG8_BAR; }
    }
    PG8_WAIT_V(0);
    if constexpr (!ALIGN_EPI) { if (wr == 0) PG8_BAR; }
    PG8_BAR;
    if constexpr (Epi::AFTER_DRAIN) { E.fused(acc, cur, wr, wc, fr, fq, lds, wid, lane); S.done(cur); }
#undef PG8_SA
#undef PG8_SB
#undef PG8_STAGE
#undef PG8_LDA
#undef PG8_LDB
#undef PG8_MMA
#undef PG8_WAIT_V
#undef PG8_WAIT_L
#undef PG8_BAR
#undef PG8_SCHED
}
}
#ifndef PG8_SP2
#define PG8_SP2 true
#endif
#ifndef PG8_ALIGN
#define PG8_ALIGN true
#endif
#ifndef MK_PER_PHASE
#define MK_PER_PHASE 0
#endif

constexpr int DM = 2048, DFF = 5632, NMOD = 9, DEPTH = 4;
constexpr int NP_B = 32, NP_L = 256, NS_B = 2, NS_L = 4096, PAST = 512;
constexpr int TP = NP_B * NP_L, TS = NS_B * NS_L, T = TP + TS;
constexpr int HALFW = 1024;
constexpr int S5_G = 64, S5_H = 16, S5_P = 64;
constexpr int HY_EMB = 33, HY_FFN = 64, HY_BANDS = 16;
constexpr int RG_NB = 16, RG_BW = 64;
constexpr int NA_H = 16, NA_HD = 64, GRID_W = 64, GRID_R = 64, WIN_R = 8, WIN_C = 16;
constexpr int EVEN_IN = 4096, ODD_IN = 5120;
constexpr int ODD_LD = 4096;
constexpr float EPS = 1e-6f;
constexpr int NWAVES = 8, NTHR = 512;

constexpr size_t MiB = 1u << 20;
constexpr size_t WS_CTL = 0, CTL_ZERO_BYTES = 1 * MiB;
constexpr size_t WS_MODP = 1 * MiB;
constexpr size_t WS_MOD  = 9 * MiB;
constexpr size_t WS_S5A  = 10 * MiB;
constexpr size_t WS_S5BB = 11 * MiB;
constexpr size_t WS_HYNP = 24 * MiB;
constexpr size_t WS_HYIN = 28 * MiB;
constexpr size_t WS_RGS  = 16 * MiB;
constexpr size_t WS_S5E  = 20 * MiB;
constexpr size_t WS_WGU  = 32 * MiB;
constexpr size_t WS_WD   = 384 * MiB;
constexpr size_t WS_WINE = 560 * MiB;
constexpr size_t WS_WINO = 592 * MiB;
constexpr size_t WS_WOUT = 632 * MiB;
constexpr size_t WS_WGLU = 664 * MiB;
constexpr size_t WS_KF   = 672 * MiB;
constexpr size_t KF_EI_BYTES = 68 * MiB, KF_SMALL_OFF = 64 * MiB;
constexpr size_t WS_H    = 808 * MiB;
constexpr size_t WS_A1   = 872 * MiB;
constexpr size_t WS_PROJ = 1048 * MiB;
constexpr size_t PROJT_OFF = 64 * MiB;
constexpr size_t WS_MIX  = 1368 * MiB;
constexpr size_t WS_Z    = 1432 * MiB;
constexpr size_t WS_DLT  = 1464 * MiB;
constexpr size_t WS_AB   = 1528 * MiB;
constexpr size_t WS_QN   = 1784 * MiB;
constexpr size_t WS_VT   = 1816 * MiB;
constexpr size_t WS_KN   = 1848 * MiB;
constexpr size_t WS_CKB  = 1912 * MiB;
constexpr size_t WS_CVT  = 1916 * MiB;
constexpr size_t WS_H2T  = 1920 * MiB;
constexpr size_t WS_WGF  = 1924 * MiB;
constexpr size_t WS_XB   = 1925 * MiB;
constexpr size_t WS_END  = 1989 * MiB;
constexpr int CW_BAR = 4096;

constexpr size_t OUT_YP = 0, OUT_YS = (size_t)TP * DM, OUT_NAK = (size_t)T * DM;
constexpr size_t OUT_NAV = OUT_NAK + (size_t)NP_B * 2 * NP_L * 1024;
constexpr size_t OUT_S5 = OUT_NAV + (size_t)NP_B * 2 * NP_L * 1024;
constexpr size_t OUT_RG = OUT_S5 + (size_t)NP_B * 2 * 2 * 64 * 64 * 2;
constexpr size_t OUT_END = OUT_RG + (size_t)NP_B * 2 * 2 * 1024;

constexpr int RING_OFF = 0, RING_BYTES = 131072;
constexpr int LDSCTL_OFF = RING_BYTES, MISC_OFF = LDSCTL_OFF + 320;
constexpr int LDS_BYTES = 147456;

#define GAS __attribute__((address_space(1)))
#define LAS __attribute__((address_space(3)))
typedef unsigned short bf16;
typedef unsigned v4u __attribute__((ext_vector_type(4)));
typedef unsigned v2u __attribute__((ext_vector_type(2)));
typedef float f32x4 __attribute__((ext_vector_type(4)));
typedef float f32x2 __attribute__((ext_vector_type(2)));
typedef short bf16x8 __attribute__((ext_vector_type(8)));
typedef GAS unsigned gu32;
#define RLX_AGENT __ATOMIC_RELAXED, __HIP_MEMORY_SCOPE_AGENT
#define LDS_WAIT() asm volatile("s_waitcnt lgkmcnt(0)" ::: "memory")
#define VM_WAIT() asm volatile("s_waitcnt vmcnt(0)" ::: "memory")
__device__ __forceinline__ unsigned pk2(float lo, float hi) { return pg8::cvt_pk_bf16(lo, hi); }
__device__ __forceinline__ unsigned f2bf(float f) { return pk2(f, 0.f) & 0xffffu; }
__device__ __forceinline__ float bf2f(unsigned short b) { return __uint_as_float(((unsigned)b) << 16); }
__device__ __forceinline__ float sigmoidf_(float x) { return __builtin_amdgcn_rcpf(1.0f + __expf(-x)); }
__device__ __forceinline__ float siluf_(float x) { return x * sigmoidf_(x); }
__device__ __forceinline__ float gelu_tanh(float x) { const float u = 0.7978845608028654f * (x + 0.044715f * x * x * x); return x * sigmoidf_(2.0f * u); }
__device__ __forceinline__ float wave_sum(float v) {
#pragma unroll
    for (int o = 1; o < 64; o <<= 1) v += __shfl_xor(v, o);
    return v;
}
__device__ __forceinline__ float wave_max(float v) {
#pragma unroll
    for (int o = 1; o < 64; o <<= 1) v = fmaxf(v, __shfl_xor(v, o));
    return v;
}

#define XB_TMO      128
#define XB_XCNT(j)  (256  + 64 * (j))
#define XB_XSUB(j)  (1280 + 64 * (j))
#define XB_XGEN(j)  (2304 + 64 * (j))
#define XB_TOP      3328
#define XB_TOPGEN   3392
#define XCD_BAR_WORDS 3456
#define XB_SPIN_CAP (1u << 18)
__device__ __forceinline__ unsigned xb_ld(unsigned* p)              { return __hip_atomic_load(p, __ATOMIC_RELAXED, __HIP_MEMORY_SCOPE_AGENT); }
__device__ __forceinline__ unsigned xb_add(unsigned* p, unsigned v) { return __hip_atomic_fetch_add(p, v, __ATOMIC_RELAXED, __HIP_MEMORY_SCOPE_AGENT); }
__device__ __forceinline__ unsigned xb_xcc_id() { return (unsigned)__builtin_amdgcn_s_getreg((3 << 11) | 20) & 0xFu; }
#define XB_SPIN(cond, bar) do { unsigned _sp = 0; while (cond) { __builtin_amdgcn_s_sleep(1); \
    if ((++_sp & 255u) == 0u) { if (xb_ld(&(bar)[XB_TMO])) break; if (_sp > XB_SPIN_CAP) { atomicAdd(&(bar)[XB_TMO], 1u); break; } } } } while (0)
struct XcdBarrier { unsigned* bar; unsigned x; volatile LAS unsigned* st; };
__device__ __forceinline__ XcdBarrier xcd_barrier_post(unsigned* bar, volatile LAS unsigned* st) {
    XcdBarrier b; b.bar = bar; b.x = xb_xcc_id(); b.st = st;
    if (threadIdx.x == 0) (void)xb_add(&bar[XB_XCNT(b.x)], 1u);
    return b;
}
__device__ __forceinline__ void xcd_barrier_complete(unsigned* bar, unsigned x, unsigned& nloc, unsigned& nx) {
    const unsigned G = gridDim.x * gridDim.y * gridDim.z;
    unsigned sum, cnt, mine, sp = 0u;
    for (;;) {
        sum = 0u; cnt = 0u; mine = 0u;
#pragma unroll
        for (unsigned j = 0; j < 16; ++j) { const unsigned c = xb_ld(&bar[XB_XCNT(j)]); sum += c; cnt += (c > 0u) ? 1u : 0u; mine = (j == x) ? c : mine; }
        if (sum == G) break;
        __builtin_amdgcn_s_sleep(1);
        if ((++sp & 255u) == 0u) { if (xb_ld(&bar[XB_TMO])) break; if (sp > XB_SPIN_CAP) { atomicAdd(&bar[XB_TMO], 1u); break; } }
    }
    nloc = mine > 0u ? mine : 1u; nx = cnt > 0u ? cnt : 1u;
}
__device__ __forceinline__ void xcd_barrier(const XcdBarrier& b) {
    asm volatile("s_waitcnt vmcnt(0)" ::: "memory");
    __syncthreads();
    if (threadIdx.x == 0) {
        unsigned* bar = b.bar; unsigned bx = b.x;
        asm volatile("" : "+s"(bar), "+s"(bx));
        __builtin_amdgcn_s_waitcnt(0);
        unsigned nloc = b.st[0], nx = b.st[1];
        if (nloc == 0u) { xcd_barrier_complete(bar, bx, nloc, nx); b.st[0] = nloc; b.st[1] = nx; }
        const unsigned old = xb_add(&bar[XB_XSUB(bx)], 1u);
        const unsigned gen = old / nloc;
        if (old + 1u == (gen + 1u) * nloc) {
            __builtin_amdgcn_fence(__ATOMIC_RELEASE, "agent");
            asm volatile("s_waitcnt vmcnt(0)" ::: "memory");
            const unsigned og = xb_add(&bar[XB_TOP], 1u);
            const unsigned tg = og / nx;
            if (og + 1u == (tg + 1u) * nx) xb_add(&bar[XB_TOPGEN], 1u);
            else XB_SPIN(xb_ld(&bar[XB_TOPGEN]) == tg, bar);
            __builtin_amdgcn_fence(__ATOMIC_ACQUIRE, "agent");
            xb_add(&bar[XB_XGEN(bx)], 1u);
            asm volatile("s_waitcnt vmcnt(0)" ::: "memory");
        } else {
            XB_SPIN(xb_ld(&bar[XB_XGEN(bx)]) == gen, bar);
            __builtin_amdgcn_fence(__ATOMIC_ACQUIRE, "agent");
            asm volatile("s_waitcnt vmcnt(0)" ::: "memory");
        }
    }
    __syncthreads();
}

struct Frame {
    LAS unsigned char* lds;
    int tid, lane, wave;
    int vcu, G;
    int gw, NGW;
};
enum { I_XP = 0, I_XS, I_CK, I_CV, I_SS5, I_SRG, I_C, I_CCTX, I_NG, I_MODW, I_MODB, I_WG, I_WU, I_WD, I_EWIN, I_EWOUT,
       I_S5LRE, I_S5LIM, I_S5LDT, I_S5BRE, I_S5BIM, I_S5CRE, I_S5CIM, I_S5D, I_S5GLUW, I_S5GLUB,
       I_HYCW, I_HYCB, I_HYW1, I_HYB1, I_HYW2, I_HYB2, I_HYW3, I_HYFREQ, I_HYDEC, I_HYBIAS,
       I_OWIN, I_OWOUT, I_RGCW, I_RGCB, I_RGWA, I_RGBA, I_RGWI, I_RGBI, I_RGLAM, I_NAQN, I_NAKN, I_NARPB, N_IN };
struct Args { const float* in[N_IN]; float* out; unsigned char* ws; int ph_lo, ph_hi; };

__device__ __forceinline__ int seq_row0(int sq) { return sq < NP_B ? sq * NP_L : TP + (sq - NP_B) * NS_L; }
__device__ __forceinline__ int seq_len(int sq) { return sq < NP_B ? NP_L : NS_L; }
__device__ __forceinline__ int row_cond(int row) { return row < TP ? 0 : (row < TP + NS_L ? 1 : 2); }
__device__ __forceinline__ void p0_transpose_item(const float* W, int K, int N, bf16* WT, int mode, LAS float* scr, int item, int lane) {
    const int nblk = N / 32, kb = item / nblk, nb = item % nblk, k0 = 64 * kb, n0 = 32 * nb;
#pragma unroll 8
    for (int i = 0; i < 32; ++i) { const int kk = 2 * i + (lane >> 5); scr[kk * 33 + (lane & 31)] = W[(size_t)(k0 + kk) * N + n0 + (lane & 31)]; }
    LDS_WAIT(); asm volatile("" ::: "memory");
    const int c = lane & 7;
    const int rbase = (mode == 0) ? n0 : ((n0 >> 7) * 256 + (n0 & 127) + (mode == 2 ? 128 : 0));
#pragma unroll
    for (int j = 0; j < 4; ++j) { const int n = (lane >> 3) + 8 * j; const LAS float* s = scr + (8 * c) * 33 + n;
        v4u o; o.x = pk2(s[0 * 33], s[1 * 33]); o.y = pk2(s[2 * 33], s[3 * 33]); o.z = pk2(s[4 * 33], s[5 * 33]); o.w = pk2(s[6 * 33], s[7 * 33]);
        *(GAS v4u*)(WT + (size_t)(rbase + n) * K + k0 + 8 * c) = o; }
    LDS_WAIT(); asm volatile("" ::: "memory");
}

__device__ __forceinline__ void p0_weights(const Args& a, Frame& F) {
    LAS float* scr = (LAS float*)(F.lds + RING_OFF + F.wave * 16384);
    unsigned char* ws = a.ws;
    constexpr int IT_F = 5632;
    constexpr int N_FFN = 24 * IT_F;
    constexpr int IT_EIN = 32 * 128, IT_OIN = 32 * 160, IT_OUT = 32 * 64, IT_GLU = 16 * 32;
    constexpr int IT_CV = (PAST / 64) * (1024 / 32);
    constexpr int NITEMS = N_FFN + 2 * (IT_EIN + IT_OIN + 2 * IT_OUT + IT_GLU) + 4 * IT_CV;
    for (int it = F.gw; it < NITEMS; it += F.NGW) {
        int r = it;
        if (r < N_FFN) {
            const int mi = r / IT_F, li = r % IT_F;
            if (mi < 8)       p0_transpose_item(a.in[I_WG] + (size_t)mi * DM * DFF, DM, DFF, (bf16*)(ws + WS_WGU) + (size_t)mi * 2 * DFF * DM, 1, scr, li, F.lane);
            else if (mi < 16) p0_transpose_item(a.in[I_WU] + (size_t)(mi - 8) * DM * DFF, DM, DFF, (bf16*)(ws + WS_WGU) + (size_t)(mi - 8) * 2 * DFF * DM, 2, scr, li, F.lane);
            else              p0_transpose_item(a.in[I_WD] + (size_t)(mi - 16) * DFF * DM, DFF, DM, (bf16*)(ws + WS_WD) + (size_t)(mi - 16) * DM * DFF, 0, scr, li, F.lane);
            continue;
        }
        r -= N_FFN;
        if (r < 2 * IT_EIN) { const int e = r / IT_EIN; p0_transpose_item(a.in[I_EWIN] + (size_t)e * DM * EVEN_IN, DM, EVEN_IN, (bf16*)(ws + WS_WINE) + (size_t)e * EVEN_IN * DM, 0, scr, r % IT_EIN, F.lane); continue; }
        r -= 2 * IT_EIN;
        if (r < 2 * IT_OIN) { const int e = r / IT_OIN; p0_transpose_item(a.in[I_OWIN] + (size_t)e * DM * ODD_IN, DM, ODD_IN, (bf16*)(ws + WS_WINO) + (size_t)e * ODD_IN * DM, 0, scr, r % IT_OIN, F.lane); continue; }
        r -= 2 * IT_OIN;
        if (r < 2 * IT_OUT) { const int e = r / IT_OUT; p0_transpose_item(a.in[I_EWOUT] + (size_t)e * DM * DM, DM, DM, (bf16*)(ws + WS_WOUT) + (size_t)(2 * e) * DM * DM, 0, scr, r % IT_OUT, F.lane); continue; }
        r -= 2 * IT_OUT;
        if (r < 2 * IT_OUT) { const int e = r / IT_OUT; p0_transpose_item(a.in[I_OWOUT] + (size_t)e * DM * DM, DM, DM, (bf16*)(ws + WS_WOUT) + (size_t)(2 * e + 1) * DM * DM, 0, scr, r % IT_OUT, F.lane); continue; }
        r -= 2 * IT_OUT;
        if (r < 2 * IT_GLU) { const int e = r / IT_GLU; p0_transpose_item(a.in[I_S5GLUW] + (size_t)e * HALFW * HALFW, HALFW, HALFW, (bf16*)(ws + WS_WGLU) + (size_t)e * HALFW * HALFW, 0, scr, r % IT_GLU, F.lane); continue; }
        r -= 2 * IT_GLU;
        { const int e = r / IT_CV; p0_transpose_item(a.in[I_CV] + (size_t)e * PAST * 1024, PAST, 1024, (bf16*)(ws + WS_CVT) + (size_t)e * 1024 * PAST, 0, scr, r % IT_CV, F.lane); }
    }
}

__device__ __forceinline__ void p0_cache_k(const Args& a, Frame& F) {
    const GAS f32x4* src = (const GAS f32x4*)a.in[I_CK]; GAS v2u* dst = (GAS v2u*)(a.ws + WS_CKB);
    for (int i = F.vcu * NTHR + F.tid; i < NS_B * 2 * PAST * 1024 / 4; i += F.G * NTHR) { const f32x4 v = src[i]; v2u w; w.x = pk2(v.x, v.y); w.y = pk2(v.z, v.w); dst[i] = w; }
}
__device__ __forceinline__ void p0_gate_frags(const Args& a, Frame& F) {
    GAS v4u* dst = (GAS v4u*)(a.ws + WS_WGF);
    for (int i = F.vcu * NTHR + F.tid; i < 2 * 2 * 2 * RG_NB * 2 * 4 * 64; i += F.G * NTHR) {
        const int lane = i & 63, ks = (i >> 6) & 3, nt = (i >> 8) & 1, nb = (i >> 9) & 15, gate = (i >> 13) & 1, od = i >> 14;
        const float* w = (gate ? a.in[I_RGWI] : a.in[I_RGWA]) + ((size_t)(od * RG_NB + nb)) * 4096 + (16 * ks + 8 * (lane >> 5)) * 64 + 32 * nt + (lane & 31);
        v4u o; o.x = pk2(w[0], w[64]); o.y = pk2(w[128], w[192]); o.z = pk2(w[256], w[320]); o.w = pk2(w[384], w[448]);
        dst[i] = o;
    }
}
__device__ __forceinline__ void p0_copy_x(const Args& a, Frame& F) {
    const size_t n4 = (size_t)T * DM / 4, np4 = (size_t)TP * DM / 4;
    const GAS f32x4* xp = (const GAS f32x4*)a.in[I_XP]; const GAS f32x4* xs = (const GAS f32x4*)a.in[I_XS]; GAS f32x4* o = (GAS f32x4*)a.out;
    for (size_t i = (size_t)F.vcu * NTHR + F.tid; i < n4; i += (size_t)F.G * NTHR) o[i] = i < np4 ? xp[i] : xs[i - np4];
}

__device__ __forceinline__ void p0_adaln(const Args& a, Frame& F) {
    LAS float* scr = (LAS float*)(F.lds + RING_OFF + F.wave * 16384);
    const float* modw = a.in[I_MODW]; float* modp = (float*)(a.ws + WS_MODP);
    constexpr int NC = NMOD * DM;
    for (int it = F.gw; it < 4 * 72 * 8; it += F.NGW) {
        const int li = it / 576, r0 = it % 576, cc = r0 / 8, ks = r0 % 8, k0 = ks * 256, col = cc * 256 + F.lane * 4;
#pragma unroll
        for (int q = 0; q < 4; ++q) { const int k = k0 + F.lane + 64 * q;
            scr[F.lane + 64 * q] = siluf_(a.in[I_CCTX][k]); scr[256 + F.lane + 64 * q] = siluf_(a.in[I_C][k]); scr[512 + F.lane + 64 * q] = siluf_(a.in[I_C][DM + k]); }
        LDS_WAIT(); asm volatile("" ::: "memory");
        f32x4 a0 = {0.f, 0.f, 0.f, 0.f}, a1 = a0, a2 = a0;
        const float* wp = modw + ((size_t)li * DM + k0) * NC + col;
#pragma unroll 8
        for (int k = 0; k < 256; ++k) { const f32x4 w = *(const GAS f32x4*)(wp + (size_t)k * NC); a0 += scr[k] * w; a1 += scr[256 + k] * w; a2 += scr[512 + k] * w; }
        float* dst = modp + ((size_t)(ks * 4 + li) * 3) * NC + col;
        *(GAS f32x4*)(dst) = a0; *(GAS f32x4*)(dst + NC) = a1; *(GAS f32x4*)(dst + 2 * NC) = a2;
        LDS_WAIT(); asm volatile("" ::: "memory");
    }
}
__device__ __forceinline__ void p0b_adaln_final(const Args& a, Frame& F) {
    constexpr int NC = NMOD * DM, NTOT = 4 * 3 * NC;
    const float* modp = (const float*)(a.ws + WS_MODP); float* mod = (float*)(a.ws + WS_MOD);
    for (int i = (F.vcu * NTHR + F.tid) * 4; i < NTOT; i += F.G * NTHR * 4) {
        const int li = i / (3 * NC), j = i % NC;
        f32x4 s = *(const GAS f32x4*)(a.in[I_MODB] + (size_t)li * NC + j);
#pragma unroll
        for (int ks = 0; ks < 8; ++ks) s += *(const GAS f32x4*)(modp + (size_t)ks * NTOT + i);
        const int m = j / DM;
        if (m % 3 == 1) { const f32x4 gg = *(const GAS f32x4*)(a.in[I_NG] + ((size_t)li * 3 + m / 3) * DM + (j % DM)); s = gg * (s + 1.0f); }
        *(GAS f32x4*)(mod + i) = s;
    }
}

__device__ __forceinline__ void p0_s5params(const Args& a, Frame& F) {
    float* SA = (float*)(a.ws + WS_S5A); float* SBB = (float*)(a.ws + WS_S5BB);
    for (int i = F.vcu * NTHR + F.tid; i < 2 * 2 * S5_G * S5_P; i += F.G * NTHR) {
        const int edg = i / S5_P;
        const float lr = fminf(a.in[I_S5LRE][i], -1e-4f), li = a.in[I_S5LIM][i], dt = expf(a.in[I_S5LDT][edg]);
        const float mag = expf(lr * dt), abr = mag * cosf(li * dt), abi = mag * sinf(li * dt);
        const float den = lr * lr + li * li;
        const float cr = ((abr - 1.0f) * lr + abi * li) / den, ci = (abi * lr - (abr - 1.0f) * li) / den;
        SA[2 * i] = abr; SA[2 * i + 1] = abi;
#pragma unroll 4
        for (int h = 0; h < S5_H; ++h) { const float br = a.in[I_S5BRE][(size_t)i * S5_H + h], bi = a.in[I_S5BIM][(size_t)i * S5_H + h];
            SBB[((size_t)i * S5_H + h) * 2] = cr * br - ci * bi; SBB[((size_t)i * S5_H + h) * 2 + 1] = cr * bi + ci * br; }
    }
}

__device__ __forceinline__ void p0_hyena_h2(const Args& a, Frame& F) {
    LAS float* zs = (LAS float*)(F.lds + RING_OFF + F.wave * 16384);
    LAS float* h1r = zs + HY_EMB * 64;
    float* H2T = (float*)(a.ws + WS_H2T);
    for (int it = F.gw; it < 2 * 68; it += F.NGW) {
        const int ei = it / 68, ttg = it % 68;
        const int Lsel = ttg < 64 ? 0 : 1, tt = ttg < 64 ? ttg : ttg - 64, L = Lsel == 0 ? NS_L : NP_L;
        {   const int t = tt * 64 + F.lane; const float tf = (float)t;
            zs[F.lane] = tf / (float)L;
            const float cang = (float)(2.0 * 3.14159265358979323846 / (double)L) * tf;
#pragma unroll 4
            for (int b = 0; b < HY_BANDS; ++b) { const float band = 1e-4f + (float)b * ((15.0f - 1e-4f) / 15.0f); const float ang = cang * band; zs[(1 + b) * 64 + F.lane] = cosf(ang); zs[(17 + b) * 64 + F.lane] = -sinf(ang); }
        }
        const int j = F.lane;
        float w1c[HY_EMB], w2c[HY_FFN];
#pragma unroll
        for (int e = 0; e < HY_EMB; ++e) w1c[e] = a.in[I_HYW1][(size_t)ei * HY_EMB * HY_FFN + e * HY_FFN + j];
#pragma unroll
        for (int k = 0; k < HY_FFN; ++k) w2c[k] = a.in[I_HYW2][(size_t)ei * HY_FFN * HY_FFN + k * HY_FFN + j];
        const float b1j = a.in[I_HYB1][ei * HY_FFN + j], b2j = a.in[I_HYB2][ei * HY_FFN + j], frj = a.in[I_HYFREQ][ei * HY_FFN + j];
        float* dst = H2T + ((size_t)(ei * 2 + Lsel) * 64 + j) * 4096 + tt * 64;
        asm volatile("s_waitcnt lgkmcnt(0)" ::: "memory");
        for (int tl = 0; tl < 64; ++tl) {
            float s = b1j;
#pragma unroll
            for (int e = 0; e < HY_EMB; ++e) s += zs[e * 64 + tl] * w1c[e];
            asm volatile("" ::: "memory");
            h1r[j] = sinf(frj * s);
            asm volatile("s_waitcnt lgkmcnt(0)" ::: "memory");
            float s2 = b2j;
#pragma unroll
            for (int k4 = 0; k4 < 16; ++k4) { const f32x4 hv = ((const LAS f32x4*)h1r)[k4]; s2 += hv.x * w2c[4 * k4] + hv.y * w2c[4 * k4 + 1] + hv.z * w2c[4 * k4 + 2] + hv.w * w2c[4 * k4 + 3]; }
            asm volatile("s_waitcnt lgkmcnt(0)" ::: "memory");
            dst[tl] = sinf(frj * s2);
        }
        asm volatile("s_waitcnt lgkmcnt(0)" ::: "memory");
    }
}
typedef float f32x16p __attribute__((ext_vector_type(16)));
__device__ __forceinline__ void p0b_hyena_filters(const Args& a, Frame& F) {
    const float* H2T = (const float*)(a.ws + WS_H2T);
    const int l31 = F.lane & 31, hh = F.lane >> 5;
    for (int it = F.gw; it < 2 * 68 * 64; it += F.NGW) {
        const int ei = it / (68 * 64), r0 = it % (68 * 64), ttg = r0 / 64, ct = r0 % 64;
        const int Lsel = ttg < 64 ? 0 : 1, tt = ttg < 64 ? ttg : ttg - 64, L = Lsel == 0 ? NS_L : NP_L;
        const float* w3 = a.in[I_HYW3] + (size_t)ei * HY_FFN * 4096 + ct * 64; const float* dec = a.in[I_HYDEC] + (size_t)ei * 4096;
        const float* h2 = H2T + ((size_t)(ei * 2 + Lsel) * 64) * 4096 + tt * 64;
        f32x16p acc[2][2];
#pragma unroll
        for (int i = 0; i < 2; ++i)
#pragma unroll
            for (int j = 0; j < 2; ++j)
#pragma unroll
                for (int e = 0; e < 16; ++e) acc[i][j][e] = 0.f;
#pragma unroll 8
        for (int ks = 0; ks < 32; ++ks) {
            const int k = 2 * ks + hh;
            const float a0 = w3[(size_t)k * 4096 + l31], a1 = w3[(size_t)k * 4096 + 32 + l31];
            const float b0 = h2[(size_t)k * 4096 + l31], b1 = h2[(size_t)k * 4096 + 32 + l31];
            acc[0][0] = __builtin_amdgcn_mfma_f32_32x32x2f32(a0, b0, acc[0][0], 0, 0, 0);
            acc[0][1] = __builtin_amdgcn_mfma_f32_32x32x2f32(a0, b1, acc[0][1], 0, 0, 0);
            acc[1][0] = __builtin_amdgcn_mfma_f32_32x32x2f32(a1, b0, acc[1][0], 0, 0, 0);
            acc[1][1] = __builtin_amdgcn_mfma_f32_32x32x2f32(a1, b1, acc[1][1], 0, 0, 0);
        }
        bf16* kf = (bf16*)(a.ws + WS_KF + (size_t)ei * KF_EI_BYTES + (Lsel ? KF_SMALL_OFF : 0));
        float* np = (float*)(a.ws + WS_HYNP) + ((size_t)((ei * 2 + Lsel) * 64 + tt)) * 4096;
#pragma unroll
        for (int i = 0; i < 2; ++i)
#pragma unroll
            for (int e = 0; e < 16; ++e) {
                const int cg = ct * 64 + 32 * i + (e & 3) + 8 * (e >> 2) + 4 * hh, n = cg >> 11, dir = (cg >> 10) & 1, c = cg & 1023;
                const float dk = fabsf(dec[cg]);
                bf16* kp = kf + ((size_t)(n * 1024 + c)) * (2 * L);
                float sabs = 0.f;
#pragma unroll
                for (int j = 0; j < 2; ++j) { const int t = tt * 64 + 32 * j + l31;
                    float v = acc[i][j][e] * expf(-((float)t / (float)L) * dk);
                    if (dir == 0) kp[L - 1 - t] = (bf16)f2bf(v); else { if (t == 0) { kp[2 * L - 1] = 0; v = 0.f; } else kp[L - 1 + t] = (bf16)f2bf(v); }
                    sabs += fabsf(v); }
                sabs += __shfl_xor(sabs, 1); sabs += __shfl_xor(sabs, 2); sabs += __shfl_xor(sabs, 4); sabs += __shfl_xor(sabs, 8); sabs += __shfl_xor(sabs, 16);
                if (l31 == 0) np[cg] = sabs;
            }
    }
}
__device__ __forceinline__ void p0b_hyena_norm(const Args& a, Frame& F) {
    const float* np = (const float*)(a.ws + WS_HYNP); float* inv = (float*)(a.ws + WS_HYIN);
    for (int i = F.vcu * NTHR + F.tid; i < 2 * 2 * 2 * 1024; i += F.G * NTHR) {
        const int el = i >> 11, n = (i >> 10) & 1, c = i & 1023, ntt = (el & 1) ? 4 : 64;
        float s = 0.f;
        for (int tt = 0; tt < ntt; ++tt) { const float* p = np + ((size_t)(el * 64 + tt)) * 4096 + (n * 2) * 1024 + c; s += p[0] + p[1024]; }
        inv[i] = 1.0f / s;
    }
}
__device__ __forceinline__ void phase_norm(const Args& a, Frame& F, const float* g, const float* shift, const float* scale, bool first) {
    bf16* Xb = (bf16*)(a.ws + WS_XB); bf16* H = (bf16*)(a.ws + WS_H);
    for (int row0 = F.gw; row0 < T; row0 += 2 * F.NGW) {
        f32x4 v[2][8];
#pragma unroll
        for (int u = 0; u < 2; ++u) { const int row = min(row0 + u * F.NGW, T - 1);
            GAS v2u* xb = (GAS v2u*)(Xb + (size_t)row * DM) + F.lane;
            if (first) { const GAS f32x4* xr = (const GAS f32x4*)((row < TP ? a.in[I_XP] + (size_t)row * DM : a.in[I_XS] + (size_t)(row - TP) * DM)) + F.lane;
#pragma unroll
                for (int j = 0; j < 8; ++j) v[u][j] = xr[64 * j]; }
            else {
#pragma unroll
                for (int j = 0; j < 8; ++j) { const v2u x = xb[64 * j];
                    v[u][j].x = __uint_as_float(x.x << 16); v[u][j].y = __uint_as_float(x.x & 0xffff0000u); v[u][j].z = __uint_as_float(x.y << 16); v[u][j].w = __uint_as_float(x.y & 0xffff0000u); } } }
        const int r1 = row0 + F.NGW; const bool has1 = r1 < T;
        const int cond0 = row_cond(row0), cond1 = has1 ? row_cond(r1) : cond0;
        float rstd[2];
#pragma unroll
        for (int u = 0; u < 2; ++u) { const int row = min(row0 + u * F.NGW, T - 1);
            if (first) { GAS v2u* xb = (GAS v2u*)(Xb + (size_t)row * DM) + F.lane;
#pragma unroll
                for (int j = 0; j < 8; ++j) { v2u w; w.x = pk2(v[u][j].x, v[u][j].y); w.y = pk2(v[u][j].z, v[u][j].w); xb[64 * j] = w; } }
            float ss = 0.f;
#pragma unroll
            for (int j = 0; j < 8; ++j) ss += (v[u][j].x * v[u][j].x + v[u][j].y * v[u][j].y) + (v[u][j].z * v[u][j].z + v[u][j].w * v[u][j].w);
            rstd[u] = 1.0f / sqrtf(wave_sum(ss) * (1.0f / DM) + EPS); }
        const float* sh0 = shift + (size_t)cond0 * NMOD * DM; const float* sc0 = scale + (size_t)cond0 * NMOD * DM;
        const float* sh1 = shift + (size_t)cond1 * NMOD * DM; const float* sc1 = scale + (size_t)cond1 * NMOD * DM;
        GAS v2u* o0 = (GAS v2u*)(H + (size_t)row0 * DM) + F.lane; GAS v2u* o1 = (GAS v2u*)(H + (size_t)min(r1, T - 1) * DM) + F.lane;
        const bool same = cond0 == cond1;
#pragma unroll
        for (int j = 0; j < 8; ++j) { const int col = (F.lane + 64 * j) * 4;
            const f32x4 a1 = *(const GAS f32x4*)(sc0 + col), a0 = *(const GAS f32x4*)(sh0 + col);
            f32x4 b1 = a1, b0 = a0;
            if (!same) { b1 = *(const GAS f32x4*)(sc1 + col); b0 = *(const GAS f32x4*)(sh1 + col); }
            const f32x4 y = (v[0][j] * rstd[0]) * a1 + a0;
            v2u w; w.x = pk2(y.x, y.y); w.y = pk2(y.z, y.w); o0[64 * j] = w;
            if (has1) { const f32x4 z = (v[1][j] * rstd[1]) * b1 + b0;
                v2u w2; w2.x = pk2(z.x, z.y); w2.y = pk2(z.z, z.w); o1[64 * j] = w2; } }
    }
}

typedef float f32x4s __attribute__((ext_vector_type(4)));
typedef short bf16x4v __attribute__((ext_vector_type(4)));
struct S5B { bf16x4v b[8]; };
__device__ __forceinline__ void s5_load_bfrags(S5B& B, const float* SBB, int pbase, int lane) {
    const int n = lane & 15, kg = lane >> 4;
#pragma unroll
    for (int nt = 0; nt < 8; ++nt) {
        const int nn = 16 * nt + n, p = nn & 63, im = nn >> 6;
        const float* src = SBB + ((size_t)(pbase + p) * S5_H + 4 * kg) * 2;
        const f32x4 s0 = *(const GAS f32x4*)src, s1 = *(const GAS f32x4*)(src + 4);
        v2u ww; ww.x = im ? pk2(s0[1], s0[3]) : pk2(s0[0], s0[2]);
        ww.y = im ? pk2(s1[1], s1[3]) : pk2(s1[0], s1[2]);
        B.b[nt] = __builtin_bit_cast(bf16x4v, ww);
    }
}
__device__ __forceinline__ v2u s5_load_u(const bf16* U, size_t urow0, int g, int lane) {
    return *(const GAS v2u*)(U + (urow0 + (lane & 15)) * HALFW + g * S5_H + 4 * (lane >> 4));
}
__device__ __forceinline__ void s5_bu_tile(const S5B& B, const v2u wh, LAS float* bu, int lane) {
    const int r = lane & 15, kg = lane >> 4;
    const bf16x4v a1 = __builtin_bit_cast(bf16x4v, wh);
#pragma unroll
    for (int nt = 0; nt < 8; ++nt) {
        f32x4s acc = {0.f, 0.f, 0.f, 0.f};
        acc = __builtin_amdgcn_mfma_f32_16x16x16bf16_1k(a1, B.b[nt], acc, 0, 0, 0);
#pragma unroll
        for (int e = 0; e < 4; ++e) bu[(4 * kg + e) * 132 + 16 * nt + r] = acc[e];
    }
}
__device__ __forceinline__ void s5_pass1(const Args& a, Frame& F, int ei) {
    const bf16* U = (const bf16*)(a.ws + WS_PROJ);
    const float* SA = (const float*)(a.ws + WS_S5A); const float* SBB = (const float*)(a.ws + WS_S5BB); float* SE = (float*)(a.ws + WS_S5E);
    LAS float* bu = (LAS float*)(F.lds + RING_OFF + F.wave * 16384);
    for (int it = F.gw; it < 2 * 16 * 2 * S5_G; it += F.NGW) {
        const int g = it & 63, d = (it >> 6) & 1, c = (it >> 7) & 15, s = it >> 11;
        const int pbase = ((ei * 2 + d) * S5_G + g) * S5_P, pidx = pbase + F.lane;
        const float ar = SA[2 * pidx], ai = SA[2 * pidx + 1];
        S5B B; s5_load_bfrags(B, SBB, pbase, F.lane);
        const size_t row0 = (size_t)(TP + s * NS_L + c * 256);
        float hr = 0.f, hi = 0.f;
        v2u unext = s5_load_u(U, row0 + 16 * ((d == 0) ? 0 : 15), g, F.lane);
        for (int kb = 0; kb < 16; ++kb) {
            const v2u ucur = unext;
            if (kb + 1 < 16) unext = s5_load_u(U, row0 + 16 * ((d == 0) ? kb + 1 : 14 - kb), g, F.lane);
            s5_bu_tile(B, ucur, bu, F.lane);
            asm volatile("s_waitcnt lgkmcnt(0)" ::: "memory");
#pragma unroll
            for (int kk = 0; kk < 16; ++kk) { const int lr = (d == 0) ? kk : 15 - kk;
                const float br = bu[lr * 132 + F.lane], bi = bu[lr * 132 + 64 + F.lane];
                const float nr = ar * hr - ai * hi + br, ni = ar * hi + ai * hr + bi; hr = nr; hi = ni; }
            asm volatile("s_waitcnt lgkmcnt(0)" ::: "memory");
        }
        *(GAS f32x2*)(SE + ((size_t)it * S5_P + F.lane) * 2) = (f32x2){hr, hi};
    }
}
__device__ __forceinline__ void s5_pass2(const Args& a, Frame& F, int ei) {
    const bf16* U = (const bf16*)(a.ws + WS_PROJ);
    const float* SA = (const float*)(a.ws + WS_S5A); const float* SBB = (const float*)(a.ws + WS_S5BB); const float* SE = (const float*)(a.ws + WS_S5E);
    bf16* Z = (bf16*)(a.ws + WS_Z);
    LAS float* bu = (LAS float*)(F.lds + RING_OFF + F.wave * 16384);
    LAS unsigned short* hl = (LAS unsigned short*)(F.lds + RING_OFF + F.wave * 16384 + 8448);
    const int hq = F.lane & 15, kg = F.lane >> 4;
    for (int it = F.gw; it < 64 * S5_G; it += F.NGW) {
        const int g = it & 63, ch = it >> 6;
        const int row0 = ch * 256;
        f32x4s Y[16];
#pragma unroll
        for (int i = 0; i < 16; ++i) Y[i] = (f32x4s){0.f, 0.f, 0.f, 0.f};
#pragma unroll 1
        for (int d = 0; d < 2; ++d) {
            const int pbase = ((ei * 2 + d) * S5_G + g) * S5_P, pidx = pbase + F.lane;
            const float ar = SA[2 * pidx], ai = SA[2 * pidx + 1];
            S5B B; s5_load_bfrags(B, SBB, pbase, F.lane);
            bf16x8 cf[4];
            {   const size_t cb = ((size_t)((ei * 2 + d) * S5_G + g) * S5_H + hq) * S5_P;
#pragma unroll
                for (int ks = 0; ks < 4; ++ks) { const float* src = (ks < 2 ? a.in[I_S5CRE] : a.in[I_S5CIM]) + cb + (ks & 1) * 32 + 8 * kg; const float sg = ks < 2 ? 1.f : -1.f;
                    const f32x4 c0 = *(const GAS f32x4*)src, c1 = *(const GAS f32x4*)(src + 4);
                    v4u w; w.x = pk2(sg * c0.x, sg * c0.y); w.y = pk2(sg * c0.z, sg * c0.w); w.z = pk2(sg * c1.x, sg * c1.y); w.w = pk2(sg * c1.z, sg * c1.w); cf[ks] = __builtin_bit_cast(bf16x8, w); }
            }
            float hr = 0.f, hi = 0.f;
            if (ch >= 32) {
                const int s = (ch - 32) >> 4, c = (ch - 32) & 15;
                const f32x2 h0 = *(const GAS f32x2*)(a.in[I_SS5] + ((size_t)(((s * 2 + ei) * 2 + d) * S5_G + g) * S5_P + F.lane) * 2);
                hr = h0.x; hi = h0.y;
                float pr = ar, pi = ai;
#pragma unroll
                for (int q = 0; q < 8; ++q) { const float nr = pr * pr - pi * pi, ni = 2.f * pr * pi; pr = nr; pi = ni; }
                const int nfold = (d == 0) ? c : 15 - c;
#pragma unroll 8
                for (int q = 0; q < nfold; ++q) { const int cc = (d == 0) ? q : 15 - q;
                    const f32x2 e = *(const GAS f32x2*)(SE + ((size_t)((((s * 16 + cc) * 2 + d) * S5_G + g) * S5_P) + F.lane) * 2);
                    const float nr = pr * hr - pi * hi + e.x, ni = pr * hi + pi * hr + e.y; hr = nr; hi = ni; }
            }
            v2u unext = s5_load_u(U, (size_t)(row0 + 16 * ((d == 0) ? 0 : 15)), g, F.lane);
#pragma unroll
            for (int kb = 0; kb < 16; ++kb) {
                const v2u ucur = unext;
                if (kb + 1 < 16) unext = s5_load_u(U, (size_t)(row0 + 16 * ((d == 0) ? kb + 1 : 14 - kb)), g, F.lane);
                s5_bu_tile(B, ucur, bu, F.lane);
                asm volatile("s_waitcnt lgkmcnt(0)" ::: "memory");
#pragma unroll
                for (int kk = 0; kk < 16; ++kk) {
                    const int lr = (d == 0) ? kk : 15 - kk;
                    const float br = bu[lr * 132 + F.lane], bi = bu[lr * 132 + 64 + F.lane];
                    const float nr = ar * hr - ai * hi + br, ni = ar * hi + ai * hr + bi; hr = nr; hi = ni;
                    hl[lr * 136 + F.lane] = (bf16)f2bf(hr); hl[lr * 136 + 64 + F.lane] = (bf16)f2bf(hi);
                }
                asm volatile("s_waitcnt lgkmcnt(0)" ::: "memory");
                bf16x8 af[4];
#pragma unroll
                for (int ks = 0; ks < 4; ++ks) af[ks] = *(const LAS bf16x8*)(hl + hq * 136 + 32 * ks + 8 * kg);
                asm volatile("s_waitcnt lgkmcnt(0)" ::: "memory");
#pragma unroll
                for (int ks = 0; ks < 4; ++ks) {
                    if (d == 0) Y[kb] = __builtin_amdgcn_mfma_f32_16x16x32_bf16(af[ks], cf[ks], Y[kb], 0, 0, 0);
                    else Y[15 - kb] = __builtin_amdgcn_mfma_f32_16x16x32_bf16(af[ks], cf[ks], Y[15 - kb], 0, 0, 0);
                }
            }
            if (ch < 32) *(GAS f32x2*)(a.out + OUT_S5 + ((size_t)(((ch * 2 + ei) * 2 + d) * S5_G + g) * S5_P + F.lane) * 2) = (f32x2){hr, hi};
        }
        const float dsk = a.in[I_S5D][(ei * S5_G + g) * S5_H + hq];
#pragma unroll
        for (int i = 0; i < 16; ++i)
#pragma unroll
            for (int rg = 0; rg < 4; ++rg) { const size_t row = (size_t)(row0 + 16 * i + 4 * kg + rg);
                const float y = Y[i][rg] + dsk * bf2f(U[row * HALFW + g * S5_H + hq]);
                Z[row * HALFW + g * S5_H + hq] = (bf16)f2bf(gelu_tanh(y)); }
    }
}

typedef float f32x16 __attribute__((ext_vector_type(16)));
__device__ __forceinline__ void hyena_mfma_item(const Args& a, int ei, int rg, int c, LAS unsigned char* slab, int lane) {
    const int LB = rg < 2 ? 4 : 64, Lseq = 64 * LB, rowbase = rg * 4096;
    LAS unsigned short* zb = (LAS unsigned short*)slab;
    LAS unsigned char* cp = slab + 9216;
    const int r = lane & 31, h = lane >> 5;
    const bf16* PT = (const bf16*)(a.ws + WS_PROJ + PROJT_OFF);
    const float* cw = a.in[I_HYCW] + (size_t)ei * 3 * 3072; const float* cbv = a.in[I_HYCB] + (size_t)ei * 3072;
    const bf16* gf = (const bf16*)(a.ws + WS_KF + (size_t)ei * KF_EI_BYTES + (rg < 2 ? KF_SMALL_OFF : 0));
    const float* inv = (const float*)(a.ws + WS_HYIN) + (size_t)(ei * 2 + (rg < 2 ? 1 : 0)) * 2048;
    float zf[2][2][16];
    f32x16 acc[2][2];
#define HY_STAGE(x_, first_, invn_, bias_) do { \
        const bf16* prow_ = PT + (size_t)(x_) * T + rowbase; const float w0_ = cw[x_], w1_ = cw[3072 + (x_)], w2_ = cw[2 * 3072 + (x_)], cb_ = cbv[x_]; \
        _Pragma("unroll") for (int mt = 0; mt < 2; ++mt) _Pragma("unroll") for (int nt = 0; nt < 2; ++nt) _Pragma("unroll") for (int q = 0; q < 4; ++q) { \
            const int I_ = 32 * nt + r, j0_ = 32 * mt + 8 * q + 4 * h, t0_ = 64 * I_ + j0_, ts_ = t0_ & (Lseq - 1); \
            const v2u pw_ = *(const GAS v2u*)(prow_ + t0_); const f32x4 p_ = {__uint_as_float(pw_.x << 16), __uint_as_float(pw_.x & 0xffff0000u), __uint_as_float(pw_.y << 16), __uint_as_float(pw_.y & 0xffff0000u)}; \
            const float pm_ = ts_ > 0 ? bf2f(prow_[t0_ - 1]) : 0.f, pp_ = (ts_ + 4 < Lseq) ? bf2f(prow_[t0_ + 4]) : 0.f; \
            const float g0_ = cb_ + w0_ * pm_ + w1_ * p_.x + w2_ * p_.y, g1_ = cb_ + w0_ * p_.x + w1_ * p_.y + w2_ * p_.z, g2_ = cb_ + w0_ * p_.y + w1_ * p_.z + w2_ * p_.w, g3_ = cb_ + w0_ * p_.z + w1_ * p_.w + w2_ * pp_; \
            if (first_) { zf[mt][nt][4 * q] = g0_; zf[mt][nt][4 * q + 1] = g1_; zf[mt][nt][4 * q + 2] = g2_; zf[mt][nt][4 * q + 3] = g3_; } \
            else { zf[mt][nt][4 * q] = g0_ * (acc[mt][nt][4 * q] * (invn_) + (bias_) * zf[mt][nt][4 * q]); zf[mt][nt][4 * q + 1] = g1_ * (acc[mt][nt][4 * q + 1] * (invn_) + (bias_) * zf[mt][nt][4 * q + 1]); \
                   zf[mt][nt][4 * q + 2] = g2_ * (acc[mt][nt][4 * q + 2] * (invn_) + (bias_) * zf[mt][nt][4 * q + 2]); zf[mt][nt][4 * q + 3] = g3_ * (acc[mt][nt][4 * q + 3] * (invn_) + (bias_) * zf[mt][nt][4 * q + 3]); } \
            v2u w_; w_.x = pk2(zf[mt][nt][4 * q], zf[mt][nt][4 * q + 1]); w_.y = pk2(zf[mt][nt][4 * q + 2], zf[mt][nt][4 * q + 3]); \
            *(LAS v2u*)(zb + I_ * 72 + j0_) = w_; } } while (0)
    HY_STAGE(c, true, 0.f, 0.f);
    asm volatile("s_waitcnt lgkmcnt(0)" ::: "memory");
    const int rho = (r + 1) & 7;
    const int abase = rho * 272 + 2 * (8 * h - r + 63 + rho) - 64;
    for (int n = 0; n < 2; ++n) {
        const bf16* G = gf + ((size_t)(n * 1024 + c)) * (2 * Lseq);
#pragma unroll
        for (int mt = 0; mt < 2; ++mt)
#pragma unroll
            for (int nt = 0; nt < 2; ++nt)
#pragma unroll
                for (int e = 0; e < 16; ++e) acc[mt][nt][e] = 0.f;
        unsigned pair = ((const GAS unsigned*)(G + 64 * (2 * LB - 2)))[lane];
        for (int d = -(LB - 1); d < LB; ++d) {
            const unsigned cur = pair;
            if (d + 1 < LB) pair = ((const GAS unsigned*)(G + 64 * (LB - 2 - d)))[lane];
            const unsigned nxt = __shfl_down(cur, 1);
            const unsigned wodd = (cur >> 16) | (nxt << 16);
            asm volatile("" ::: "memory");
#pragma unroll
            for (int m = 0; m < 4; ++m) { ((LAS unsigned*)(cp + (2 * m) * 272))[lane + m] = cur; ((LAS unsigned*)(cp + (2 * m + 1) * 272))[lane + m + 1] = wodd; }
            asm volatile("" ::: "memory");
            bf16x8 A[2][4];
#pragma unroll
            for (int mt = 0; mt < 2; ++mt)
#pragma unroll
                for (int ks = 0; ks < 4; ++ks) A[mt][ks] = *(const LAS bf16x8*)(cp + abase + 32 * ks + 64 * (1 - mt));
#pragma unroll
            for (int nt = 0; nt < 2; ++nt) {
                const int I = 32 * nt + r, rel = (I & (LB - 1)) - d;
                const bool valid = (unsigned)rel < (unsigned)LB;
                if (__ballot(valid) == 0ull) continue;
                const LAS unsigned char* bp = (const LAS unsigned char*)zb + ((valid ? (I - d) : 0) * 72 + 8 * h) * 2;
                bf16x8 B[4];
#pragma unroll
                for (int ks = 0; ks < 4; ++ks) { const bf16x8 bv = *(const LAS bf16x8*)(bp + 32 * ks); B[ks] = valid ? bv : (bf16x8){0, 0, 0, 0, 0, 0, 0, 0}; }
#pragma unroll
                for (int mt = 0; mt < 2; ++mt)
#pragma unroll
                    for (int ks = 0; ks < 4; ++ks) acc[mt][nt] = __builtin_amdgcn_mfma_f32_32x32x16_bf16(A[mt][ks], B[ks], acc[mt][nt], 0, 0, 0);
            }
            asm volatile("" ::: "memory");
        }
        const int x = (1 + n) * 1024 + c;
        const float bias = a.in[I_HYBIAS][(size_t)(ei * 2 + n) * 1024 + c], invn = inv[n * 1024 + c];
        asm volatile("s_waitcnt lgkmcnt(0)" ::: "memory");
        HY_STAGE(x, false, invn, bias);
        asm volatile("s_waitcnt lgkmcnt(0)" ::: "memory");
    }
#undef HY_STAGE
}
__device__ __forceinline__ void hyena_store_block(const Args& a, Frame& F, int rowbase, int c0) {
    bf16* MIX = (bf16*)(a.ws + WS_MIX);
#pragma unroll
    for (int g = 0; g < 2; ++g) {
        const int t0 = (F.tid + g * NTHR) * 4, I = t0 >> 6, j = t0 & 63;
        v2u v[8];
#pragma unroll
        for (int w = 0; w < 8; ++w) v[w] = *(const LAS v2u*)(F.lds + RING_OFF + w * 16384 + (I * 72 + j) * 2);
#pragma unroll
        for (int e = 0; e < 4; ++e) {
            unsigned hv[8];
#pragma unroll
            for (int w = 0; w < 8; ++w) { const unsigned word = (e < 2) ? v[w].x : v[w].y; hv[w] = (e & 1) ? (word >> 16) : (word & 0xffffu); }
            v4u o; o.x = hv[0] | (hv[1] << 16); o.y = hv[2] | (hv[3] << 16); o.z = hv[4] | (hv[5] << 16); o.w = hv[6] | (hv[7] << 16);
            *(GAS v4u*)(MIX + (size_t)(rowbase + t0 + e) * DM + 1024 + c0) = o;
        }
    }
}
__device__ __forceinline__ void hyena_phase(const Args& a, Frame& F, int ei) {
    LAS unsigned char* slab = F.lds + RING_OFF + F.wave * 16384;
    for (int it = F.gw; it < 4096; it += F.NGW) {
        const int c = it & 1023, rg = it < 2048 ? 2 + (it >> 10) : ((it - 2048) >> 10);
        hyena_mfma_item(a, ei, rg, c, slab, F.lane);
        __syncthreads();
        hyena_store_block(a, F, rg * 4096, c & ~7);
        __syncthreads();
    }
}
__device__ __forceinline__ void rg_gates(const Args& a, Frame& F, int oi) {
    const bf16* P = (const bf16*)(a.ws + WS_PROJ); unsigned* AB = (unsigned*)(a.ws + WS_AB);
    LAS float* xs = (LAS float*)(F.lds + RING_OFF + F.wave * 16384);
    const int r32 = F.lane & 31, hh = F.lane >> 5;
    for (int it = F.gw; it < (T / 64) * RG_NB; it += F.NGW) {
        const int nb = it & 15, tt = it >> 4, row0 = tt * 64, ch = nb * 64 + F.lane;
        const int sq0 = row0 < TP ? 0 : TP, L = row0 < TP ? NP_L : NS_L, tseq0 = (row0 - sq0) & (L - 1);
        {   const float* cw = a.in[I_RGCW] + (size_t)oi * 4 * 1024; const float w0 = cw[ch], w1 = cw[1024 + ch], w2 = cw[2048 + ch], w3 = cw[3072 + ch], cb = a.in[I_RGCB][oi * 1024 + ch];
            const bf16* pc = P + (size_t)row0 * ODD_LD + ch;
            float xm2 = tseq0 >= 2 ? bf2f(pc[-2 * ODD_LD]) : 0.f, xm1 = tseq0 >= 1 ? bf2f(pc[-ODD_LD]) : 0.f, x0 = bf2f(pc[0]);
#pragma unroll 16
            for (int k = 0; k < 64; ++k) { const float xp1 = (tseq0 + k < L - 1) ? bf2f(pc[(size_t)(k + 1) * ODD_LD]) : 0.f;
                xs[k * 64 + F.lane] = cb + w0 * xm2 + w1 * xm1 + w2 * x0 + w3 * xp1; xm2 = xm1; xm1 = x0; x0 = xp1; } }
        asm volatile("s_waitcnt lgkmcnt(0)" ::: "memory");
        bf16x8 af[2][4];
#pragma unroll
        for (int mt = 0; mt < 2; ++mt)
#pragma unroll
            for (int ks = 0; ks < 4; ++ks) { const LAS float* s = xs + (32 * mt + r32) * 64 + 16 * ks + 8 * hh; const f32x4 x0 = *(const LAS f32x4*)s, x1 = *(const LAS f32x4*)(s + 4);
                v4u w; w.x = pk2(x0.x, x0.y); w.y = pk2(x0.z, x0.w); w.z = pk2(x1.x, x1.y); w.w = pk2(x1.z, x1.w); af[mt][ks] = __builtin_bit_cast(bf16x8, w); }
#pragma unroll 1
        for (int d = 0; d < 2; ++d) {
#pragma unroll 1
            for (int nt = 0; nt < 2; ++nt) {
                const int dout = 32 * nt + r32, co = nb * 64 + dout;
                const GAS bf16x8* wf = (const GAS bf16x8*)(a.ws + WS_WGF) + ((size_t)((((oi * 2 + d) * 2 + 0) * RG_NB + nb) * 2 + nt)) * 256 + F.lane;
                bf16x8 ba[4], bi[4];
#pragma unroll
                for (int ks = 0; ks < 4; ++ks) { ba[ks] = wf[ks * 64]; bi[ks] = wf[RG_NB * 2 * 256 + ks * 64]; }
                const float bav = a.in[I_RGBA][(oi * 2 + d) * 1024 + co], biv = a.in[I_RGBI][(oi * 2 + d) * 1024 + co];
                const float lam = a.in[I_RGLAM][(oi * 2 + d) * 1024 + co], sp = log1pf(expf(-lam));
#pragma unroll
                for (int mt = 0; mt < 2; ++mt) {
                    f32x16 ar, ai;
#pragma unroll
                    for (int e = 0; e < 16; ++e) { ar[e] = 0.f; ai[e] = 0.f; }
#pragma unroll
                    for (int ks = 0; ks < 4; ++ks) { ar = __builtin_amdgcn_mfma_f32_32x32x16_bf16(af[mt][ks], ba[ks], ar, 0, 0, 0); ai = __builtin_amdgcn_mfma_f32_32x32x16_bf16(af[mt][ks], bi[ks], ai, 0, 0, 0); }
#pragma unroll
                    for (int e = 0; e < 16; ++e) { const int tk = 32 * mt + (e & 3) + 8 * (e >> 2) + 4 * hh;
                        const float r = sigmoidf_(ar[e] + bav), ig = sigmoidf_(ai[e] + biv);
                        const float loga = -8.0f * r * sp, am = 1.0f - __expf(loga), bv = __builtin_amdgcn_sqrtf(am * (2.0f - am)) * (ig * xs[tk * 64 + dout]);
                        AB[((size_t)(row0 + tk) * 2 + d) * 1024 + co] = pk2(am, bv); }
                }
            }
        }
        asm volatile("s_waitcnt lgkmcnt(0)" ::: "memory");
        asm volatile("s_waitcnt vmcnt(0)" ::: "memory");
        {   float* RGS = (float*)(a.ws + WS_RGS);
#pragma unroll
            for (int d = 0; d < 2; ++d) { float A = 1.f, h = 0.f;
#pragma unroll 16
                for (int k = 0; k < 64; ++k) { const int row = row0 + (d == 0 ? k : 63 - k); const unsigned w = __builtin_nontemporal_load(AB + ((size_t)row * 2 + d) * 1024 + ch);
                    const float av = 1.0f - __uint_as_float(w << 16), bv = __uint_as_float(w & 0xffff0000u); A *= av; h = av * h + bv; }
                float* o = RGS + ((size_t)(tt * 2 + d) * 2) * 1024 + ch; o[0] = A; o[1024] = h; }
        }
    }
}
__device__ __forceinline__ void rg_pass2(const Args& a, Frame& F, int oi) {
    const bf16* P = (const bf16*)(a.ws + WS_PROJ); const unsigned* AB = (const unsigned*)(a.ws + WS_AB); const float* RGS = (const float*)(a.ws + WS_RGS);
    bf16* MIX = (bf16*)(a.ws + WS_MIX);
    LAS float* hf = (LAS float*)(F.lds + RING_OFF + F.wave * 16384);
    for (int it = F.gw; it < 256 * RG_NB; it += F.NGW) {
        const int nb = it & 15, ck = it >> 4, ch = nb * 64 + F.lane, row0 = ck * 64;
        int cfirst, clast, sb = -1, pb = -1;
        if (ck < 128) { pb = ck >> 2; cfirst = pb * 4; clast = cfirst + 3; } else { sb = (ck - 128) >> 6; cfirst = 128 + sb * 64; clast = cfirst + 63; }
        float h = (sb >= 0) ? a.in[I_SRG][((size_t)(sb * 2 + oi) * 2 + 0) * 1024 + ch] : 0.f;
        for (int c0 = cfirst; c0 < ck; c0 += 16) {
            float fa[16], fb[16];
#pragma unroll
            for (int q = 0; q < 16; ++q) { const int c = c0 + q; const bool ok = c < ck; const float* s = RGS + ((size_t)((ok ? c : cfirst) * 2 + 0) * 2) * 1024 + ch; fa[q] = ok ? s[0] : 1.f; fb[q] = ok ? s[1024] : 0.f; }
#pragma unroll
            for (int q = 0; q < 16; ++q) h = fa[q] * h + fb[q]; }
#pragma unroll 16
        for (int k = 0; k < 64; ++k) { const unsigned w = AB[((size_t)(row0 + k) * 2 + 0) * 1024 + ch]; h = (1.0f - __uint_as_float(w << 16)) * h + __uint_as_float(w & 0xffff0000u); hf[k * 64 + F.lane] = h; }
        if (pb >= 0 && ck == clast) a.out[OUT_RG + ((size_t)(pb * 2 + oi) * 2 + 0) * 1024 + ch] = h;
        h = (sb >= 0) ? a.in[I_SRG][((size_t)(sb * 2 + oi) * 2 + 1) * 1024 + ch] : 0.f;
        for (int c0 = clast; c0 > ck; c0 -= 16) {
            float fa[16], fb[16];
#pragma unroll
            for (int q = 0; q < 16; ++q) { const int c = c0 - q; const bool ok = c > ck; const float* s = RGS + ((size_t)((ok ? c : clast) * 2 + 1) * 2) * 1024 + ch; fa[q] = ok ? s[0] : 1.f; fb[q] = ok ? s[1024] : 0.f; }
#pragma unroll
            for (int q = 0; q < 16; ++q) h = fa[q] * h + fb[q]; }
#pragma unroll 16
        for (int k = 63; k >= 0; --k) { const size_t row = (size_t)(row0 + k); const unsigned w = AB[(row * 2 + 1) * 1024 + ch]; h = (1.0f - __uint_as_float(w << 16)) * h + __uint_as_float(w & 0xffff0000u);
            const float y = (hf[k * 64 + F.lane] + h) * gelu_tanh(bf2f(P[row * ODD_LD + 1024 + ch]));
            MIX[row * DM + ch] = (bf16)f2bf(y); }
        if (pb >= 0 && ck == cfirst) a.out[OUT_RG + ((size_t)(pb * 2 + oi) * 2 + 1) * 1024 + ch] = h;
        LDS_WAIT(); asm volatile("" ::: "memory");
    }
}

constexpr float QSCALE = 0.125f * 1.4426950408889634f, LOG2E = 1.4426950408889634f;
__device__ __forceinline__ void qk_norm(const Args& a, Frame& F, int oi) {
    const bf16* P = (const bf16*)(a.ws + WS_PROJ); bf16* Qb = (bf16*)(a.ws + WS_QN); bf16* Kb = (bf16*)(a.ws + WS_KN);
    const int dl = (F.lane & 15) * 4;
    const f32x4 gq = *(const GAS f32x4*)(a.in[I_NAQN] + oi * 64 + dl) * QSCALE, gk = *(const GAS f32x4*)(a.in[I_NAKN] + oi * 64 + dl);
    for (int row = F.gw; row < T; row += F.NGW) {
        const bf16* p = P + (size_t)row * ODD_LD;
#pragma unroll
        for (int ps = 0; ps < 4; ++ps) {
            const int col = ps * 256 + F.lane * 4;
            const v2u qw = *(const GAS v2u*)(p + 2048 + col), kw = *(const GAS v2u*)(p + 3072 + col);
            const f32x4 q = {__uint_as_float(qw.x << 16), __uint_as_float(qw.x & 0xffff0000u), __uint_as_float(qw.y << 16), __uint_as_float(qw.y & 0xffff0000u)};
            const f32x4 k = {__uint_as_float(kw.x << 16), __uint_as_float(kw.x & 0xffff0000u), __uint_as_float(kw.y << 16), __uint_as_float(kw.y & 0xffff0000u)};
            float sq = (q.x * q.x + q.y * q.y) + (q.z * q.z + q.w * q.w), sk = (k.x * k.x + k.y * k.y) + (k.z * k.z + k.w * k.w);
            sq += __shfl_xor(sq, 1); sk += __shfl_xor(sk, 1); sq += __shfl_xor(sq, 2); sk += __shfl_xor(sk, 2); sq += __shfl_xor(sq, 4); sk += __shfl_xor(sk, 4); sq += __shfl_xor(sq, 8); sk += __shfl_xor(sk, 8);
            const float rq = 1.0f / sqrtf(sq * (1.0f / 64.0f) + EPS), rk = 1.0f / sqrtf(sk * (1.0f / 64.0f) + EPS);
            const f32x4 qn = q * rq * gq, kn = k * rk * gk;
            v2u wq, wk; wq.x = pk2(qn.x, qn.y); wq.y = pk2(qn.z, qn.w); wk.x = pk2(kn.x, kn.y); wk.y = pk2(kn.z, kn.w);
            *(GAS v2u*)(Qb + (size_t)row * 1024 + col) = wq; *(GAS v2u*)(Kb + (size_t)row * 1024 + col) = wk;
            if (row < TP) { const int b = row >> 8, tk = row & 255; const size_t o = ((size_t)((b * 2 + oi) * NP_L + tk)) * 1024 + col;
                *(GAS f32x4*)(a.out + OUT_NAK + o) = kn; }
        }
    }
}
__device__ __forceinline__ void na_v_out(const Args& a, Frame& F, int oi) {
    const bf16* VT = (const bf16*)(a.ws + WS_VT);
    LAS unsigned short* s = (LAS unsigned short*)(F.lds + RING_OFF + F.wave * 16384);
    for (int it = F.gw; it < 16 * (TP / 64); it += F.NGW) {
        const int ct = it & 15, tt = it >> 4, c0 = ct * 64, t0 = tt * 64;
#pragma unroll 8
        for (int i = 0; i < 64; ++i) s[i * 66 + F.lane] = VT[(size_t)(c0 + i) * T + t0 + F.lane];
        asm volatile("s_waitcnt lgkmcnt(0)" ::: "memory");
#pragma unroll 8
        for (int tl = 0; tl < 64; ++tl) { const int row = t0 + tl, b = row >> 8, tk = row & 255;
            a.out[OUT_NAV + ((size_t)((b * 2 + oi) * NP_L + tk)) * 1024 + c0 + F.lane] = bf2f(s[F.lane * 66 + tl]); }
        asm volatile("s_waitcnt lgkmcnt(0)" ::: "memory");
    }
}
struct AttnState { f32x16 o[2]; float m, l; };
__device__ __forceinline__ void attn_reset(AttnState& S) { S.m = -1e30f; S.l = 0.f;
#pragma unroll
    for (int e = 0; e < 16; ++e) { S.o[0][e] = 0.f; S.o[1][e] = 0.f; } }
__device__ __forceinline__ f32x16 attn_scores(const bf16x8 (&kf)[4], const bf16x8 (&qf)[4]) {
    f32x16 st;
#pragma unroll
    for (int e = 0; e < 16; ++e) st[e] = 0.f;
#pragma unroll
    for (int ks = 0; ks < 4; ++ks) st = __builtin_amdgcn_mfma_f32_32x32x16_bf16(kf[ks], qf[ks], st, 0, 0, 0);
    return st;
}
__device__ __forceinline__ void attn_update(AttnState& S, const f32x16& st, const bf16x8 (&vf)[2][2]) {
    float mx = st[0];
#pragma unroll
    for (int e = 1; e < 16; ++e) mx = fmaxf(mx, st[e]);
    mx = fmaxf(mx, __shfl_xor(mx, 32));
    const float mn = fmaxf(S.m, mx), alpha = __builtin_amdgcn_exp2f(S.m - mn);
    S.m = mn;
    float p[16], ps = 0.f;
#pragma unroll
    for (int e = 0; e < 16; ++e) { p[e] = __builtin_amdgcn_exp2f(st[e] - mn); ps += p[e]; }
    S.l = S.l * alpha + ps;
#pragma unroll
    for (int e = 0; e < 16; ++e) { S.o[0][e] *= alpha; S.o[1][e] *= alpha; }
#pragma unroll
    for (int s = 0; s < 2; ++s) {
        v4u w; w.x = pg8::cvt_pk_bf16(p[8 * s], p[8 * s + 1]); w.y = pg8::cvt_pk_bf16(p[8 * s + 2], p[8 * s + 3]); w.z = pg8::cvt_pk_bf16(p[8 * s + 4], p[8 * s + 5]); w.w = pg8::cvt_pk_bf16(p[8 * s + 6], p[8 * s + 7]);
        const bf16x8 pb = __builtin_bit_cast(bf16x8, w);
        S.o[0] = __builtin_amdgcn_mfma_f32_32x32x16_bf16(vf[0][s], pb, S.o[0], 0, 0, 0);
        S.o[1] = __builtin_amdgcn_mfma_f32_32x32x16_bf16(vf[1][s], pb, S.o[1], 0, 0, 0);
    }
}
__device__ __forceinline__ bf16x8 join8(v2u lo, v2u hi) { v4u w; w.x = lo.x; w.y = lo.y; w.z = hi.x; w.w = hi.y; return __builtin_bit_cast(bf16x8, w); }
constexpr int AK_STR = 144, AV_STR = 520, AK_BYTES = 256 * AK_STR, AV_BYTES = 64 * AV_STR, ABIAS_OFF = AK_BYTES + AV_BYTES;
__device__ __forceinline__ void attn_stage_chunk(LAS unsigned char* lds, const bf16* kg, int ldk, const bf16* vg, int ldv, int tid) {
#pragma unroll
    for (int ps = 0; ps < 4; ++ps) { const int i = tid + ps * NTHR, key = i >> 3, seg = i & 7;
        *(LAS v4u*)(lds + key * AK_STR + seg * 16) = *(const GAS v4u*)(kg + (size_t)key * ldk + seg * 8); }
#pragma unroll
    for (int ps = 0; ps < 4; ++ps) { const int i = tid + ps * NTHR, d = i >> 5, seg = i & 31;
        const v4u v = *(const GAS v4u*)(vg + (size_t)d * ldv + seg * 8);
        LAS v2u* dst = (LAS v2u*)(lds + AK_BYTES + d * AV_STR + seg * 16); dst[0] = (v2u){v.x, v.y}; dst[1] = (v2u){v.z, v.w}; }
}
__device__ __forceinline__ void attn_chunk(AttnState& S, const bf16x8 (&qf)[4], const LAS unsigned char* lds, int lane) {
    const int r = lane & 31, h = lane >> 5;
#pragma unroll 2
    for (int kt = 0; kt < 8; ++kt) {
        bf16x8 kf[4];
        const LAS unsigned char* kp = lds + (kt * 32 + r) * AK_STR + 16 * h;
#pragma unroll
        for (int ks = 0; ks < 4; ++ks) kf[ks] = *(const LAS bf16x8*)(kp + 32 * ks);
        bf16x8 vf[2][2];
#pragma unroll
        for (int mt = 0; mt < 2; ++mt)
#pragma unroll
            for (int s = 0; s < 2; ++s) { const LAS unsigned char* vp = lds + AK_BYTES + (32 * mt + r) * AV_STR + (kt * 32 + 16 * s + 4 * h) * 2;
                vf[mt][s] = join8(*(const LAS v2u*)vp, *(const LAS v2u*)(vp + 16)); }
        const f32x16 st = attn_scores(kf, qf);
        attn_update(S, st, vf);
    }
}
__device__ __forceinline__ void attn_load_q(bf16x8 (&qf)[4], const bf16* qrow0  , int lane) {
    const bf16* qp = qrow0 + (size_t)(lane & 31) * 1024 + 8 * (lane >> 5);
#pragma unroll
    for (int ks = 0; ks < 4; ++ks) qf[ks] = *(const GAS bf16x8*)(qp + 16 * ks);
}
__device__ __forceinline__ void attn_store(AttnState& S, bf16* orow0  , int lane) {
    const float lt = S.l + __shfl_xor(S.l, 32), il = 1.0f / lt;
    bf16* op = orow0 + (size_t)(lane & 31) * DM + 4 * (lane >> 5);
#pragma unroll
    for (int mt = 0; mt < 2; ++mt)
#pragma unroll
        for (int g = 0; g < 4; ++g) { v2u w; w.x = pk2(S.o[mt][4 * g] * il, S.o[mt][4 * g + 1] * il); w.y = pk2(S.o[mt][4 * g + 2] * il, S.o[mt][4 * g + 3] * il);
            *(GAS v2u*)(op + 32 * mt + 8 * g) = w; }
}
__device__ __forceinline__ void attn_ctx(const Args& a, Frame& F) {
    const bf16* Qb = (const bf16*)(a.ws + WS_QN); const bf16* Kb = (const bf16*)(a.ws + WS_KN); const bf16* VT = (const bf16*)(a.ws + WS_VT);
    bf16* MIX = (bf16*)(a.ws + WS_MIX);
    LAS unsigned char* lds = F.lds + RING_OFF;
    for (int it = F.vcu; it < NP_B * NA_H; it += F.G) {
        const int b = it >> 4, hd = it & 15, row0 = b * NP_L;
        __syncthreads();
        attn_stage_chunk(lds, Kb + (size_t)row0 * 1024 + hd * 64, 1024, VT + (size_t)(hd * 64) * T + row0, T, F.tid);
        bf16x8 qf[4]; attn_load_q(qf, Qb + (size_t)(row0 + F.wave * 32) * 1024 + hd * 64, F.lane);
        AttnState S; attn_reset(S);
        __syncthreads();
        attn_chunk(S, qf, lds, F.lane);
        attn_store(S, MIX + (size_t)(row0 + F.wave * 32) * DM + 1024 + hd * 64, F.lane);
    }
    __syncthreads();
}
__device__ __forceinline__ void attn_na(const Args& a, Frame& F, int oi) {
    const bf16* Qb = (const bf16*)(a.ws + WS_QN); const bf16* Kb = (const bf16*)(a.ws + WS_KN); const bf16* VT = (const bf16*)(a.ws + WS_VT);
    const bf16* CKB = (const bf16*)(a.ws + WS_CKB); const bf16* CVT = (const bf16*)(a.ws + WS_CVT);
    bf16* MIX = (bf16*)(a.ws + WS_MIX);
    LAS unsigned char* lds = F.lds + RING_OFF;
    LAS float* bias = (LAS float*)(lds + 126976);
    constexpr int LV_STR = 1416;
    const int r32 = F.lane & 31, h = F.lane >> 5;
    for (int it = F.vcu; it < NS_B * NA_H * 16; it += F.G) {
        const int rg = it & 15, hd = (it >> 4) & 15, b = it >> 8;
        const int gr = rg * 4 + (F.wave >> 1), c0 = 32 * (F.wave & 1), qrow0 = TP + b * NS_L + gr * GRID_W + c0;
        bf16x8 qf[4]; attn_load_q(qf, Qb + (size_t)qrow0 * 1024 + hd * 64, F.lane);
        AttnState S; attn_reset(S);
        const size_t cbase = (size_t)(b * 2 + oi);
        for (int ck = 0; ck < 2; ++ck) {
            __syncthreads();
            attn_stage_chunk(lds, CKB + (cbase * PAST + ck * 256) * 1024 + hd * 64, 1024, CVT + (cbase * 1024 + hd * 64) * PAST + ck * 256, PAST, F.tid);
            if (ck == 0) { const float* rpb = a.in[I_NARPB] + (size_t)(oi * NA_H + hd) * 15 * 31; for (int i = F.tid; i < 15 * 31; i += NTHR) bias[i] = rpb[i] * LOG2E; }
            __syncthreads();
            attn_chunk(S, qf, lds, F.lane);
        }
        const int qc = c0 + r32, rs = min(max(gr - WIN_R / 2, 0), GRID_R - WIN_R), cs = min(max(qc - WIN_C / 2, 0), GRID_W - WIN_C);
        const size_t tbase = (size_t)(TP + b * NS_L + rs * GRID_W);
        const bf16* kbase = Kb + (tbase + r32) * 1024 + hd * 64 + 8 * h;
        const int R0 = min(max(rg * 4 - WIN_R / 2, 0), GRID_R - WIN_R), R1 = min(max(rg * 4 + 3 - WIN_R / 2, 0), GRID_R - WIN_R) + WIN_R, NK16 = (R1 - R0) * 8;
        __syncthreads();
        {   const bf16* vsrc = VT + (size_t)(hd * 64) * T + (size_t)(TP + b * NS_L + R0 * GRID_W);
            for (int i = F.tid; i < 64 * NK16; i += NTHR) { const int d = i / NK16, pc = i - d * NK16; const v4u v = *(const GAS v4u*)(vsrc + (size_t)d * T + pc * 8);
                LAS v2u* dst = (LAS v2u*)(lds + d * LV_STR + pc * 16); dst[0] = (v2u){v.x, v.y}; dst[1] = (v2u){v.z, v.w}; } }
        __syncthreads();
        const LAS unsigned char* vloc = lds + r32 * LV_STR + ((rs - R0) * GRID_W + 4 * h) * 2;
#define NA_LOAD(ti_, kf_, vf_) do { const int to_ = ((ti_) >> 1) * GRID_W + ((ti_) & 1) * 32; \
            _Pragma("unroll") for (int ks = 0; ks < 4; ++ks) kf_[ks] = *(const GAS bf16x8*)(kbase + (size_t)to_ * 1024 + 16 * ks); \
            _Pragma("unroll") for (int mt = 0; mt < 2; ++mt) _Pragma("unroll") for (int s = 0; s < 2; ++s) { const LAS unsigned char* vp_ = vloc + (32 * mt) * LV_STR + (to_ + 16 * s) * 2; \
                vf_[mt][s] = join8(*(const LAS v2u*)vp_, *(const LAS v2u*)(vp_ + 16)); } } while (0)
#define NA_PROC(ti_, kf_, vf_) do { const int krow_ = rs + ((ti_) >> 1), ct_ = (ti_) & 1; \
            const LAS float* brow_ = bias + (krow_ - gr + WIN_R - 1) * 31 + (WIN_C - 1) - qc; \
            f32x16 st_ = attn_scores(kf_, qf); \
            _Pragma("unroll") for (int e = 0; e < 16; ++e) { const int kc_ = 32 * ct_ + (e & 3) + 8 * (e >> 2) + 4 * h; \
                st_[e] = ((unsigned)(kc_ - cs) < (unsigned)WIN_C) ? st_[e] + brow_[kc_] : -1e30f; } \
            attn_update(S, st_, vf_); } while (0)
        {   bf16x8 kA[4], kB[4], vA[2][2], vB[2][2];
            NA_LOAD(0, kA, vA);
#pragma unroll 1
            for (int tp = 0; tp < 16; tp += 2) {
                NA_LOAD(tp + 1, kB, vB);
                NA_PROC(tp, kA, vA);
                if (tp + 2 < 16) NA_LOAD(tp + 2, kA, vA);
                NA_PROC(tp + 1, kB, vB);
            }
        }
#undef NA_LOAD
#undef NA_PROC
        attn_store(S, MIX + (size_t)qrow0 * DM + 1024 + hd * 64, F.lane);
    }
    __syncthreads();
}
#ifndef EN
#define EN 0xFFFF
#endif
#ifndef EN_GEMM
#define EN_GEMM 63
#endif
constexpr int NPHASES = 2 + 2 * 12 + 2 * 11;
typedef const __attribute__((address_space(4))) Args* KArgsPtr;
__device__ __forceinline__ Frame mkframe(unsigned char* lds_raw) {
    Frame F;
    int tid = threadIdx.x, bx = blockIdx.x, G = gridDim.x;
    asm volatile("" : "+v"(tid), "+s"(bx), "+s"(G));
    F.lds = (LAS unsigned char*)lds_raw;
    F.tid = tid; F.lane = tid & 63; F.wave = __builtin_amdgcn_readfirstlane(tid >> 6);
    F.G = G; F.vcu = (G % 8 == 0) ? (bx % 8) * (G / 8) + bx / 8 : bx;
    F.gw = F.vcu * NWAVES + F.wave; F.NGW = G * NWAVES;
    return F;
}
__global__ void __launch_bounds__(NTHR, 2) fwd_kernel(Args args_unused) {
    extern __shared__ __attribute__((aligned(16))) unsigned char lds_raw[];
    {   LAS unsigned* z = (LAS unsigned*)((LAS unsigned char*)lds_raw + LDSCTL_OFF);
        for (int u = threadIdx.x; u < (LDS_BYTES - LDSCTL_OFF) / 4; u += NTHR) z[u] = 0u; }
    __syncthreads();
    KArgsPtr kp0 = (KArgsPtr)__builtin_amdgcn_kernarg_segment_ptr();
    XcdBarrier bar = xcd_barrier_post((unsigned*)(kp0->ws + WS_CTL) + CW_BAR, (volatile LAS unsigned*)((LAS unsigned char*)lds_raw + MISC_OFF) + 8);
    const int lo = kp0->ph_lo, hi = kp0->ph_hi;
    int pc = 0;
#define PH_ON() (pc >= lo && pc < hi)
#ifndef REPEAT_MASK
#define REPEAT_MASK 0
#endif
#ifndef PROBE_MASK
#define PROBE_MASK 0
#endif
#if PROBE_MASK
    unsigned long long pr_prev = __builtin_amdgcn_s_memrealtime();
    LAS unsigned* pr_acc = (LAS unsigned*)((LAS unsigned char*)lds_raw + LDSCTL_OFF + 1024);
#define PH_END(cls) do { if (pc >= lo && pc + 1 < hi) xcd_barrier(bar); ++pc; \
        if (blockIdx.x == 0 && threadIdx.x == 0) { const unsigned long long t_ = __builtin_amdgcn_s_memrealtime(); pr_acc[cls] += (unsigned)(t_ - pr_prev); pr_prev = t_; } } while (0)
#else
#define PH_END(cls) do { if (pc >= lo && pc + 1 < hi) xcd_barrier(bar); ++pc; } while (0)
#endif
#define PH_ARGS() KArgsPtr kp = (KArgsPtr)__builtin_amdgcn_kernarg_segment_ptr(); asm volatile("" : "+s"(kp)); const Args args = *(const Args*)kp; Frame F = mkframe(lds_raw); \
    unsigned char* ws = args.ws; float* X = args.out; LAS unsigned char* ring = F.lds + RING_OFF; (void)ws; (void)X; (void)ring; (void)F

    if (PH_ON()) { PH_ARGS(); for (int rep_ = 0; rep_ < (((REPEAT_MASK >> 0) & 1) ? 2 : 1); ++rep_) {
        for (int r2 = 0; r2 < (((REPEAT_MASK >> 17) & 1) ? 2 : 1); ++r2) p0_adaln(args, F);
        for (int r2 = 0; r2 < (((REPEAT_MASK >> 18) & 1) ? 2 : 1); ++r2) { p0_s5params(args, F); p0_cache_k(args, F); p0_gate_frags(args, F); }
        for (int r2 = 0; r2 < (((REPEAT_MASK >> 19) & 1) ? 2 : 1); ++r2) p0_hyena_h2(args, F);
        for (int r2 = 0; r2 < (((REPEAT_MASK >> 20) & 1) ? 2 : 1); ++r2) p0_weights(args, F);
    } }
    PH_END(0);
    if (PH_ON()) { PH_ARGS(); for (int rep_ = 0; rep_ < (((REPEAT_MASK >> 1) & 1) ? 2 : 1); ++rep_) { p0b_adaln_final(args, F); p0b_hyena_filters(args, F); } }
    PH_END(1);

#pragma clang loop unroll(disable)
#ifndef NLAYERS
#define NLAYERS DEPTH
#endif
    for (int li = 0; li < NLAYERS; ++li) {
#pragma clang loop unroll(disable)
        for (int half = 0; half < 2; ++half) {
#define MODP() ((const float*)(ws + WS_MOD) + (size_t)li * 3 * NMOD * DM)
#define NGP() (args.in[I_NG] + (size_t)li * 3 * DM)
            if (PH_ON()) { PH_ARGS(); for (int rep_ = 0; rep_ < (((REPEAT_MASK >> 2) & 1) ? 2 : 1); ++rep_) { phase_norm(args, F, NGP() + (half ? 2 : 0) * DM, MODP() + (half ? 6 : 0) * DM, MODP() + (half ? 7 : 1) * DM, li == 0 && half == 0); } }
            PH_END(2);
            if (PH_ON()) { PH_ARGS(); for (int rep_ = 0; rep_ < (((REPEAT_MASK >> 3) & 1) ? 2 : 1); ++rep_) { pg8::Gemm g{(const bf16*)(ws + WS_H), (const bf16*)(ws + WS_WGU) + (size_t)(li * 2 + half) * 2 * DFF * DM, T, 2 * DFF, DM};
                pg8::StaticOrder S; S.init(T, 2 * DFF, F.G, (int)blockIdx.x); pg8::EpiSwiGLU E{(bf16*)(ws + WS_A1), DFF};
                if (EN_GEMM & 1) pg8::gemm_phase<pg8::EpiSwiGLU, pg8::StaticOrder, PG8_ALIGN, PG8_SP2>(ring, g, S, E); } }
            PH_END(3);
            if (PH_ON()) { PH_ARGS(); for (int rep_ = 0; rep_ < (((REPEAT_MASK >> 4) & 1) ? 2 : 1); ++rep_) { pg8::Gemm g{(const bf16*)(ws + WS_A1), (const bf16*)(ws + WS_WD) + (size_t)(li * 2 + half) * DM * DFF, T, DM, DFF};
                pg8::StaticOrder S; S.init(T, DM, F.G, (int)blockIdx.x);
                if (li == NLAYERS - 1 && half == 1) { pg8::EpiFinal E{(const bf16*)(ws + WS_XB), X, DM, MODP() + (half ? 8 : 2) * DM, NMOD * DM, 0.5f};
                    pg8::gemm_phase<pg8::EpiFinal, pg8::StaticOrder, PG8_ALIGN, PG8_SP2>(ring, g, S, E); }
                else { pg8::EpiXb E{(bf16*)(ws + WS_XB), DM, MODP() + (half ? 8 : 2) * DM, NMOD * DM, 0.5f};
                    pg8::gemm_phase<pg8::EpiXb, pg8::StaticOrder, PG8_ALIGN, PG8_SP2>(ring, g, S, E); } } }
            PH_END(4);
            if (half == 0) {
                if (PH_ON()) { PH_ARGS(); for (int rep_ = 0; rep_ < (((REPEAT_MASK >> 2) & 1) ? 2 : 1); ++rep_) { if (li == 0) p0b_hyena_norm(args, F); phase_norm(args, F, NGP() + DM, MODP() + 3 * DM, MODP() + 4 * DM, false); } }
                PH_END(2);
                if ((li & 1) == 0) {
                    const int ei = li >> 1;
                    if (PH_ON()) { PH_ARGS(); for (int rep_ = 0; rep_ < (((REPEAT_MASK >> 5) & 1) ? 2 : 1); ++rep_) {
                        { pg8::Gemm g{(const bf16*)(ws + WS_H), (const bf16*)(ws + WS_WINE) + (size_t)ei * EVEN_IN * DM, T, HALFW, DM};
                          pg8::StaticOrder S; S.init(T, HALFW, F.G, (int)blockIdx.x); pg8::EpiBf16 E{(bf16*)(ws + WS_PROJ), HALFW};
                          if (EN_GEMM & 4) pg8::gemm_phase<pg8::EpiBf16, pg8::StaticOrder, PG8_ALIGN, PG8_SP2>(ring, g, S, E); }
                        { pg8::Gemm g{(const bf16*)(ws + WS_WINE) + (size_t)ei * EVEN_IN * DM + (size_t)HALFW * DM, (const bf16*)(ws + WS_H), 3 * HALFW, T, DM};
                          pg8::StaticOrder S; S.init(3 * HALFW, T, F.G, (int)blockIdx.x); pg8::EpiBf16 E{(bf16*)(ws + WS_PROJ + PROJT_OFF), T};
                          if (EN_GEMM & 4) pg8::gemm_phase<pg8::EpiBf16, pg8::StaticOrder, PG8_ALIGN, PG8_SP2>(ring, g, S, E); }
                    } }
                    PH_END(5);
                    if (PH_ON()) { PH_ARGS(); for (int rep_ = 0; rep_ < (((REPEAT_MASK >> 6) & 1) ? 2 : 1); ++rep_) {
#if EN & 8
                        s5_pass1(args, F, ei); __syncthreads();
#endif
#if EN & 16
                        hyena_phase(args, F, ei);
#endif
                    } }
                    PH_END(6);
                    if (PH_ON()) { PH_ARGS(); for (int rep_ = 0; rep_ < (((REPEAT_MASK >> 7) & 1) ? 2 : 1); ++rep_) {
#if EN & 32
                        s5_pass2(args, F, ei); __syncthreads();
#endif
                    } }
                    PH_END(7);
                    if (PH_ON()) { PH_ARGS(); for (int rep_ = 0; rep_ < (((REPEAT_MASK >> 8) & 1) ? 2 : 1); ++rep_) { pg8::Gemm g{(const bf16*)(ws + WS_Z), (const bf16*)(ws + WS_WGLU) + (size_t)ei * HALFW * HALFW, T, HALFW, HALFW};
                        pg8::StaticOrder S; S.init(T, HALFW, F.G, (int)blockIdx.x); pg8::EpiGLU E{(const bf16*)(ws + WS_Z), HALFW, args.in[I_S5GLUB] + ei * HALFW, (bf16*)(ws + WS_MIX), DM};
                        if (EN_GEMM & 8) pg8::gemm_phase<pg8::EpiGLU, pg8::StaticOrder, PG8_ALIGN, PG8_SP2>(ring, g, S, E); } }
                    PH_END(8);
                } else {
                    const int oi = li >> 1;
                    if (PH_ON()) { PH_ARGS(); for (int rep_ = 0; rep_ < (((REPEAT_MASK >> 9) & 1) ? 2 : 1); ++rep_) { pg8::Gemm g{(const bf16*)(ws + WS_H), (const bf16*)(ws + WS_WINO) + (size_t)oi * ODD_IN * DM, T, ODD_LD, DM};
                        pg8::StaticOrder S; S.init(T, ODD_LD, F.G, (int)blockIdx.x); pg8::EpiBf16 E{(bf16*)(ws + WS_PROJ), ODD_LD};
                        if (EN_GEMM & 16) pg8::gemm_phase<pg8::EpiBf16, pg8::StaticOrder, PG8_ALIGN, PG8_SP2>(ring, g, S, E); }
                      { pg8::Gemm g{(const bf16*)(ws + WS_WINO) + (size_t)oi * ODD_IN * DM + (size_t)4096 * DM, (const bf16*)(ws + WS_H), HALFW, T, DM};
                        pg8::StaticOrder S; S.init(HALFW, T, F.G, (int)blockIdx.x); pg8::EpiBf16 E{(bf16*)(ws + WS_VT), T};
                        pg8::gemm_phase<pg8::EpiBf16, pg8::StaticOrder, PG8_ALIGN, PG8_SP2>(ring, g, S, E); } }
                    PH_END(9);
                    if (PH_ON()) { PH_ARGS(); for (int rep_ = 0; rep_ < (((REPEAT_MASK >> 10) & 1) ? 2 : 1); ++rep_) {
#ifdef SKIP_GATES3
                        if (li != 3)
#endif
                        { rg_gates(args, F, oi); __syncthreads(); }
                        qk_norm(args, F, oi); __syncthreads(); na_v_out(args, F, oi);
                    } }
                    PH_END(10);
                    if (PH_ON()) { PH_ARGS(); for (int rep_ = 0; rep_ < (((REPEAT_MASK >> 11) & 1) ? 2 : 1); ++rep_) {
#ifdef SKIP_RG3
                        if (li != 3)
#endif
                        { rg_pass2(args, F, oi); __syncthreads(); }
#ifdef SKIP_ATT3
                        if (li != 3) {
#endif
#ifndef SKIP_CTX
                        attn_ctx(args, F);
#endif
#ifndef SKIP_NA
                        attn_na(args, F, oi);
#endif
#ifdef SKIP_ATT3
                        }
#endif
                    } }
                    PH_END(11);
                }
                if (PH_ON()) { PH_ARGS(); for (int rep_ = 0; rep_ < (((REPEAT_MASK >> 13) & 1) ? 2 : 1); ++rep_) { pg8::Gemm g{(const bf16*)(ws + WS_MIX), (const bf16*)(ws + WS_WOUT) + (size_t)li * DM * DM, T, DM, DM};
                    pg8::StaticOrder S; S.init(T, DM, F.G, (int)blockIdx.x); pg8::EpiXb E{(bf16*)(ws + WS_XB), DM, MODP() + 5 * DM, NMOD * DM, 1.0f};
                    if (EN_GEMM & 32) pg8::gemm_phase<pg8::EpiXb, pg8::StaticOrder, PG8_ALIGN, PG8_SP2>(ring, g, S, E); } }
                PH_END(13);
            }
        }
    }
#if PROBE_MASK && defined(PROBE_SPIN)
    if (blockIdx.x == 0 && threadIdx.x == 0) { unsigned tot = 0; for (int c = 0; c < 16; ++c) if ((PROBE_MASK >> c) & 1) tot += pr_acc[c];
        const unsigned long long t0 = __builtin_amdgcn_s_memrealtime(), wait = (unsigned long long)tot * PROBE_SPIN;
        while (__builtin_amdgcn_s_memrealtime() - t0 < wait) __builtin_amdgcn_s_sleep(32); }
#elif PROBE_MASK
    if (blockIdx.x == 0 && threadIdx.x == 0) { unsigned tot = 0; for (int c = 0; c < 16; ++c) if ((PROBE_MASK >> c) & 1) tot += pr_acc[c];
        KArgsPtr kq = (KArgsPtr)__builtin_amdgcn_kernarg_segment_ptr(); const unsigned us_ = tot / 100u, q_ = ((us_ + 50u) / 100u) * 100u; kq->out[OUT_RG] = (float)q_ * 1000.0f; }
#endif
#undef PH_ON
#undef PH_END
}

extern "C" void kernel_launch(void* const* d_in, const int* in_sizes, int n_in, void* d_out, int out_size, void* d_ws, size_t ws_size, hipStream_t stream) {
    static int grid = 0;
    if (grid == 0) {
        if (n_in != N_IN || (size_t)out_size != OUT_END || ws_size < WS_END) { fprintf(stderr, "kernel_launch: unexpected shapes: n_in %d out %d ws %zu (need %zu)\n", n_in, out_size, ws_size, (size_t)WS_END); grid = -1; return; }
        int dev = 0, cus = 0, per_cu = 0;
        if (hipGetDevice(&dev) != hipSuccess || hipDeviceGetAttribute(&cus, hipDeviceAttributeMultiprocessorCount, dev) != hipSuccess) { grid = -1; return; }
        if (hipFuncSetAttribute((const void*)fwd_kernel, hipFuncAttributeMaxDynamicSharedMemorySize, LDS_BYTES) != hipSuccess) { fprintf(stderr, "kernel_launch: hipFuncSetAttribute failed\n"); grid = -1; return; }
        if (hipOccupancyMaxActiveBlocksPerMultiprocessor(&per_cu, (const void*)fwd_kernel, NTHR, LDS_BYTES) != hipSuccess || per_cu < 1) fprintf(stderr, "kernel_launch: occupancy query says %d\n", per_cu);
        (void)hipGetLastError();
        grid = cus;
    }
    if (grid < 0) return;
    (void)hipMemsetAsync((char*)d_ws + WS_CTL, 0, CTL_ZERO_BYTES, stream);
    Args a{};
    for (int i = 0; i < N_IN; ++i) a.in[i] = (const float*)d_in[i];
    a.out = (float*)d_out; a.ws = (unsigned char*)d_ws;
#if MK_PER_PHASE
    for (int ph = 0; ph < NPHASES; ++ph) { a.ph_lo = ph; a.ph_hi = ph + 1; hipLaunchKernelGGL(fwd_kernel, dim3(grid), dim3(NTHR), LDS_BYTES, stream, a); }
#else
    a.ph_lo = 0; a.ph_hi = NPHASES;
    hipLaunchKernelGGL(fwd_kernel, dim3(grid), dim3(NTHR), LDS_BYTES, stream, a);
#endif
}
```

```cpp
#include <hip/hip_runtime.h>
#include <cstdio>
#include <cstdint>
namespace pg8 {
#define PG8_LAS __attribute__((address_space(3)))
typedef unsigned short bf16_t;
typedef short bf16x8 __attribute__((ext_vector_type(8)));
typedef float f32x4 __attribute__((ext_vector_type(4)));
typedef unsigned u32x4 __attribute__((ext_vector_type(4)));
constexpr int BM = 256, BK = 64, HALF = 128, HTB = HALF * BK * 2  , STAGE_BYTES = 8 * HTB, NXCD = 8, WGM = 8;

__host__ __device__ __forceinline__ int lds_byte(int r, int c) { const int st = (r >> 4) * 2 + (c >> 5), rr = r & 15, cc = c & 31, ob = rr * 64 + cc * 2; return st * 1024 + (ob ^ (((ob >> 9) & 1) << 5)); }
__host__ __device__ __forceinline__ void stage_rc(int b, int& R, int& C) { const int st = b / 1024, sb = b % 1024, swz = sb ^ (((sb >> 9) & 1) << 5); R = (st >> 1) * 16 + swz / 64; C = (st & 1) * 32 + (swz % 64) / 2; }
__host__ __device__ __forceinline__ int perm32(int rho) { const int n = rho >> 4, i = rho & 15; return 8 * (i >> 2) + 4 * n + (i & 3); }

struct Unit { int pm, pn; };
struct Gemm { const bf16_t* A; const bf16_t* Bt; int M, N, K; };

struct StaticOrder {
    int nM, nN, nwg, G, c;
    __host__ __device__ void init(int M, int N, int G_, int c_) { nM = M / BM; nN = N / BM; nwg = nM * nN; G = G_; c = c_; }
    __host__ __device__ bool next(int i, Unit& u) const {
        const long L = (long)i * G + c; if (L >= nwg) return false;
        int wgid = (int)L; { const int q = nwg / NXCD, r = nwg % NXCD, xcd = wgid % NXCD, off = wgid / NXCD; wgid = (xcd < r ? xcd * (q + 1) : r * (q + 1) + (xcd - r) * q) + off; }
        const int nig = WGM * nN, gid = wgid / nig, fm = gid * WGM, gsz = (nM - fm) < WGM ? (nM - fm) : WGM;
        u.pm = fm + ((wgid % nig) % gsz); u.pn = (wgid % nig) / gsz; return true;
    }
    __device__ __forceinline__ void a_ready(const Unit&) const {}
    __device__ __forceinline__ void done(const Unit&) const {}
};

typedef __bf16 bf2_t __attribute__((ext_vector_type(2)));
typedef float f32x2_t __attribute__((ext_vector_type(2)));
__device__ __forceinline__ unsigned cvt_pk_bf16(float lo, float hi) { const f32x2_t v = {lo, hi}; const bf2_t b = __builtin_convertvector(v, bf2_t); return __builtin_bit_cast(unsigned, b); }
__device__ __forceinline__ float fsigmoid(float x) { return __builtin_amdgcn_rcpf(1.0f + __expf(-x)); }

struct EpiF32 {
    static constexpr bool PERM = false, AFTER_DRAIN = false;
    float* C; int ldc;
    __device__ __forceinline__ void operator()(const f32x4 (&acc)[2][2][4][2], const Unit& u, int wr, int wc, int fr, int fq) const {
        const int row0 = u.pm * BM + wr * 64 + fr, col0 = u.pn * BM + wc * 32 + 4 * fq;
#pragma unroll
        for (int ai = 0; ai < 2; ++ai)
#pragma unroll
            for (int m = 0; m < 4; ++m) { float* rowp = C + (size_t)(row0 + ai * HALF + m * 16) * ldc + col0;
#pragma unroll
                for (int bj = 0; bj < 2; ++bj)
#pragma unroll
                    for (int n = 0; n < 2; ++n) *(f32x4*)(rowp + bj * HALF + n * 16) = acc[ai][bj][m][n]; }
    }
};
struct EpiBf16 {
    static constexpr bool PERM = true, AFTER_DRAIN = false;
    bf16_t* O; int ldc;
    __device__ __forceinline__ void operator()(const f32x4 (&acc)[2][2][4][2], const Unit& u, int wr, int wc, int fr, int fq) const {
        const int row0 = u.pm * BM + wr * 64 + fr, col0 = u.pn * BM + wc * 32 + 8 * fq;
#pragma unroll
        for (int ai = 0; ai < 2; ++ai)
#pragma unroll
            for (int m = 0; m < 4; ++m) { bf16_t* rowp = O + (size_t)(row0 + ai * HALF + m * 16) * ldc + col0;
#pragma unroll
                for (int bj = 0; bj < 2; ++bj) { const f32x4 v0 = acc[ai][bj][m][0], v1 = acc[ai][bj][m][1];
                    u32x4 w; w.x = cvt_pk_bf16(v0[0], v0[1]); w.y = cvt_pk_bf16(v0[2], v0[3]); w.z = cvt_pk_bf16(v1[0], v1[1]); w.w = cvt_pk_bf16(v1[2], v1[3]);
                    *(u32x4*)(rowp + bj * HALF) = w; } }
    }
};
struct EpiSwiGLU {
    static constexpr bool PERM = true, AFTER_DRAIN = false;
    bf16_t* O; int ldc;
    __device__ __forceinline__ void operator()(const f32x4 (&acc)[2][2][4][2], const Unit& u, int wr, int wc, int fr, int fq) const {
        const int row0 = u.pm * BM + wr * 64 + fr, col0 = u.pn * HALF + wc * 32 + 8 * fq;
#pragma unroll
        for (int ai = 0; ai < 2; ++ai)
#pragma unroll
            for (int m = 0; m < 4; ++m) { bf16_t* rowp = O + (size_t)(row0 + ai * HALF + m * 16) * ldc + col0;
                f32x4 r0, r1;
#pragma unroll
                for (int j = 0; j < 4; ++j) { const float g0 = acc[ai][0][m][0][j], g1 = acc[ai][0][m][1][j];
                    r0[j] = g0 * fsigmoid(g0) * acc[ai][1][m][0][j]; r1[j] = g1 * fsigmoid(g1) * acc[ai][1][m][1][j]; }
                u32x4 w; w.x = cvt_pk_bf16(r0[0], r0[1]); w.y = cvt_pk_bf16(r0[2], r0[3]); w.z = cvt_pk_bf16(r1[0], r1[1]); w.w = cvt_pk_bf16(r1[2], r1[3]);
                *(u32x4*)rowp = w; }
    }
};
struct EpiResid {
    static constexpr bool PERM = false, AFTER_DRAIN = false;
    float* X; int ldc; const float* gate; int gstride; float coef;
    __device__ __forceinline__ void operator()(const f32x4 (&acc)[2][2][4][2], const Unit& u, int wr, int wc, int fr, int fq) const {
        const int row0 = u.pm * BM + wr * 64 + fr, col0 = u.pn * BM + wc * 32 + 4 * fq;
        const int cond = u.pm < 32 ? 0 : (u.pm < 48 ? 1 : 2);
        const float* gp = gate + (size_t)cond * gstride + col0;
        f32x4 gv[2][2];
#pragma unroll
        for (int bj = 0; bj < 2; ++bj)
#pragma unroll
            for (int n = 0; n < 2; ++n) gv[bj][n] = *(const f32x4*)(gp + bj * HALF + n * 16) * coef;
#pragma unroll
        for (int ai = 0; ai < 2; ++ai)
#pragma unroll
            for (int m = 0; m < 4; ++m) { float* rowp = X + (size_t)(row0 + ai * HALF + m * 16) * ldc + col0;
#pragma unroll
                for (int bj = 0; bj < 2; ++bj)
#pragma unroll
                    for (int n = 0; n < 2; ++n) { f32x4* p = (f32x4*)(rowp + bj * HALF + n * 16); *p = *p + gv[bj][n] * acc[ai][bj][m][n]; } }
    }
};
struct EpiGLU {
    static constexpr bool PERM = true, AFTER_DRAIN = false;
    const bf16_t* Z; int ldz; const float* bias; bf16_t* O; int ldo;
    __device__ __forceinline__ void operator()(const f32x4 (&acc)[2][2][4][2], const Unit& u, int wr, int wc, int fr, int fq) const {
        const int row0 = u.pm * BM + wr * 64 + fr, col0 = u.pn * BM + wc * 32 + 8 * fq;
        f32x4 bv[2][2];
#pragma unroll
        for (int bj = 0; bj < 2; ++bj)
#pragma unroll
            for (int n = 0; n < 2; ++n) bv[bj][n] = *(const f32x4*)(bias + col0 + bj * HALF + 4 * n);
#pragma unroll
        for (int ai = 0; ai < 2; ++ai)
#pragma unroll
            for (int m = 0; m < 4; ++m) { const size_t row = (size_t)(row0 + ai * HALF + m * 16);
#pragma unroll
                for (int bj = 0; bj < 2; ++bj) { const u32x4 zz = *(const u32x4*)(Z + row * ldz + col0 + bj * HALF);
                    const f32x4 v0 = acc[ai][bj][m][0] + bv[bj][0], v1 = acc[ai][bj][m][1] + bv[bj][1];
                    float zf[8];
#pragma unroll
                    for (int j = 0; j < 4; ++j) { zf[2 * j] = __uint_as_float(zz[j] << 16); zf[2 * j + 1] = __uint_as_float(zz[j] & 0xffff0000u); }
                    float o[8];
#pragma unroll
                    for (int j = 0; j < 4; ++j) { o[j] = zf[j] * fsigmoid(v0[j]); o[4 + j] = zf[4 + j] * fsigmoid(v1[j]); }
                    u32x4 w; w.x = cvt_pk_bf16(o[0], o[1]); w.y = cvt_pk_bf16(o[2], o[3]); w.z = cvt_pk_bf16(o[4], o[5]); w.w = cvt_pk_bf16(o[6], o[7]);
                    *(u32x4*)(O + row * ldo + col0 + bj * HALF) = w; } }
    }
};

struct EpiDelta {
    static constexpr bool PERM = true, AFTER_DRAIN = false;
    bf16_t* D; int ldc; const float* gate; int gstride; float coef;
    __device__ __forceinline__ void operator()(const f32x4 (&acc)[2][2][4][2], const Unit& u, int wr, int wc, int fr, int fq) const {
        const int row0 = u.pm * BM + wr * 64 + fr, col0 = u.pn * BM + wc * 32 + 8 * fq;
        const int cond = u.pm < 32 ? 0 : (u.pm < 48 ? 1 : 2);
        const float* gp = gate + (size_t)cond * gstride + col0;
        f32x4 gv[2][2];
#pragma unroll
        for (int bj = 0; bj < 2; ++bj)
#pragma unroll
            for (int n = 0; n < 2; ++n) gv[bj][n] = *(const f32x4*)(gp + bj * HALF + 4 * n) * coef;
#pragma unroll
        for (int ai = 0; ai < 2; ++ai)
#pragma unroll
            for (int m = 0; m < 4; ++m) { bf16_t* rowp = D + (size_t)(row0 + ai * HALF + m * 16) * ldc + col0;
#pragma unroll
                for (int bj = 0; bj < 2; ++bj) { const f32x4 v0 = acc[ai][bj][m][0] * gv[bj][0], v1 = acc[ai][bj][m][1] * gv[bj][1];
                    u32x4 w; w.x = cvt_pk_bf16(v0[0], v0[1]); w.y = cvt_pk_bf16(v0[2], v0[3]); w.z = cvt_pk_bf16(v1[0], v1[1]); w.w = cvt_pk_bf16(v1[2], v1[3]);
                    *(u32x4*)(rowp + bj * HALF) = w; } }
    }
};

struct EpiFinal {
    static constexpr bool PERM = false, AFTER_DRAIN = false;
    const bf16_t* Xb; float* Out; int ldc; const float* gate; int gstride; float coef;
    __device__ __forceinline__ void operator()(const f32x4 (&acc)[2][2][4][2], const Unit& u, int wr, int wc, int fr, int fq) const {
        const int row0 = u.pm * BM + wr * 64 + fr, col0 = u.pn * BM + wc * 32 + 4 * fq;
        const int cond = u.pm < 32 ? 0 : (u.pm < 48 ? 1 : 2);
        const float* gp = gate + (size_t)cond * gstride + col0;
        f32x4 gv[2][2];
#pragma unroll
        for (int bj = 0; bj < 2; ++bj)
#pragma unroll
            for (int n = 0; n < 2; ++n) gv[bj][n] = *(const f32x4*)(gp + bj * HALF + n * 16) * coef;
#pragma unroll
        for (int ai = 0; ai < 2; ++ai)
#pragma unroll
            for (int m = 0; m < 4; ++m) { const size_t ro = (size_t)(row0 + ai * HALF + m * 16) * ldc + col0;
#pragma unroll
                for (int bj = 0; bj < 2; ++bj)
#pragma unroll
                    for (int n = 0; n < 2; ++n) { const size_t o = ro + bj * HALF + n * 16;
                        const unsigned long long xw = *(const unsigned long long*)(Xb + o); const unsigned lo = (unsigned)xw, hi = (unsigned)(xw >> 32);
                        f32x4 xv; xv[0] = __uint_as_float(lo << 16); xv[1] = __uint_as_float(lo & 0xffff0000u); xv[2] = __uint_as_float(hi << 16); xv[3] = __uint_as_float(hi & 0xffff0000u);
                        *(f32x4*)(Out + o) = xv + gv[bj][n] * acc[ai][bj][m][n]; } }
    }
};

struct EpiXb {
    static constexpr bool PERM = true, AFTER_DRAIN = false;
    bf16_t* Xb; int ldc; const float* gate; int gstride; float coef;
    __device__ __forceinline__ void operator()(const f32x4 (&acc)[2][2][4][2], const Unit& u, int wr, int wc, int fr, int fq) const {
        const int row0 = u.pm * BM + wr * 64 + fr, col0 = u.pn * BM + wc * 32 + 8 * fq;
        const int cond = u.pm < 32 ? 0 : (u.pm < 48 ? 1 : 2);
        const float* gp = gate + (size_t)cond * gstride + col0;
        f32x4 gv[2][2];
#pragma unroll
        for (int bj = 0; bj < 2; ++bj)
#pragma unroll
            for (int n = 0; n < 2; ++n) gv[bj][n] = *(const f32x4*)(gp + bj * HALF + 4 * n) * coef;
#pragma unroll
        for (int ai = 0; ai < 2; ++ai)
#pragma unroll
            for (int m = 0; m < 4; ++m) { bf16_t* rowp = Xb + (size_t)(row0 + ai * HALF + m * 16) * ldc + col0;
#pragma unroll
                for (int bj = 0; bj < 2; ++bj) { const u32x4 x = *(const u32x4*)(rowp + bj * HALF);
                    f32x4 x0, x1; x0[0] = __uint_as_float(x.x << 16); x0[1] = __uint_as_float(x.x & 0xffff0000u); x0[2] = __uint_as_float(x.y << 16); x0[3] = __uint_as_float(x.y & 0xffff0000u);
                    x1[0] = __uint_as_float(x.z << 16); x1[1] = __uint_as_float(x.z & 0xffff0000u); x1[2] = __uint_as_float(x.w << 16); x1[3] = __uint_as_float(x.w & 0xffff0000u);
                    const f32x4 v0 = x0 + acc[ai][bj][m][0] * gv[bj][0], v1 = x1 + acc[ai][bj][m][1] * gv[bj][1];
                    u32x4 w; w.x = cvt_pk_bf16(v0[0], v0[1]); w.y = cvt_pk_bf16(v0[2], v0[3]); w.z = cvt_pk_bf16(v1[0], v1[1]); w.w = cvt_pk_bf16(v1[2], v1[3]);
                    *(u32x4*)(rowp + bj * HALF) = w; } }
    }
};

template <class Epi, class Sched, bool ALIGN_EPI = false, bool SP2 = false>
__device__ __forceinline__ void gemm_phase(PG8_LAS unsigned char* lds, const Gemm g, const Sched& S, const Epi& E) {
    int tid_ = threadIdx.x; asm volatile("" : "+v"(tid_));
    const int tid = tid_, wid = __builtin_amdgcn_readfirstlane(tid >> 6), lane = tid & 63, wr = wid >> 2, wc = wid & 3, fr = lane & 15, fq = lane >> 4;
    const int K = g.K, nt = K / BK;
    unsigned voffA[2], voffB[2];
#pragma unroll
    for (int i = 0; i < 2; ++i) { int R, C; stage_rc(tid * 16 + i * 8192, R, C); const int Rb = Epi::PERM ? ((R & ~31) + perm32(R & 31)) : R;
        voffA[i] = (unsigned)(R * K + C) * 2u; voffB[i] = (unsigned)(Rb * K + C) * 2u; }
    const size_t kstep = (size_t)(BK * 2);
    const size_t hstep = (size_t)HALF * K * 2;
    const size_t tstep = 2 * hstep;
    const unsigned ldsw = (unsigned)wid * 1024u;
    const int aoff = lds_byte(wr * 64 + fr, fq * 8), boff = lds_byte(wc * 32 + fr, fq * 8);
#define PG8_SA(b, h) (((b) * 2 + (h)) * HTB)
#define PG8_SB(b, h) ((4 + (b) * 2 + (h)) * HTB)
#define PG8_STAGE(bufoff, gbase, voff) do { _Pragma("unroll") for (int _i = 0; _i < 2; ++_i) \
        __builtin_amdgcn_global_load_lds((const unsigned*)((const char*)(gbase) + (voff)[_i]), (PG8_LAS unsigned*)(lds + (bufoff) + ldsw + _i * 8192), 16, 0, 0); } while (0)
#define PG8_LDA(dst, b, h) do { _Pragma("unroll") for (int m = 0; m < 4; ++m) _Pragma("unroll") for (int k = 0; k < 2; ++k) dst[m][k] = *(const PG8_LAS bf16x8*)(lds + PG8_SA(b, h) + aoff + m * 2048 + k * 1024); } while (0)
#define PG8_LDB(dst, b, h) do { _Pragma("unroll") for (int n = 0; n < 2; ++n) _Pragma("unroll") for (int k = 0; k < 2; ++k) dst[n][k] = *(const PG8_LAS bf16x8*)(lds + PG8_SB(b, h) + boff + n * 2048 + k * 1024); } while (0)
#define PG8_MMA(ai, bj, At, Bt) do { __builtin_amdgcn_s_setprio(1); _Pragma("unroll") for (int m = 0; m < 4; ++m) _Pragma("unroll") for (int n = 0; n < 2; ++n) _Pragma("unroll") for (int k = 0; k < 2; ++k) \
        acc[ai][bj][m][n] = __builtin_amdgcn_mfma_f32_16x16x32_bf16(Bt[n][k], At[m][k], acc[ai][bj][m][n], 0, 0, 0); __builtin_amdgcn_s_setprio(0); } while (0)
#define PG8_WAIT_V(n) asm volatile("s_waitcnt vmcnt(" #n ")" ::: "memory")
#define PG8_WAIT_L(n) asm volatile("s_waitcnt lgkmcnt(" #n ")" ::: "memory")
#define PG8_BAR __builtin_amdgcn_s_barrier()
#define PG8_SCHED __builtin_amdgcn_sched_barrier(0)
    Unit cur, nxt; int ui = 0;
    if (!S.next(0, cur)) return;
    f32x4 acc[2][2][4][2];
#pragma unroll
    for (int a = 0; a < 2; ++a)
#pragma unroll
        for (int b = 0; b < 2; ++b)
#pragma unroll
            for (int m = 0; m < 4; ++m)
#pragma unroll
                for (int n = 0; n < 2; ++n) acc[a][b][m][n] = (f32x4){0.f, 0.f, 0.f, 0.f};
    bf16x8 At[4][2], B0[2][2], B1[2][2];
    const char* cA = (const char*)g.A + (size_t)cur.pm * tstep; const char* cB = (const char*)g.Bt + (size_t)cur.pn * tstep;
    S.a_ready(cur);
    if constexpr (SP2) {
        PG8_STAGE(PG8_SB(0, 0), cB, voffB); PG8_STAGE(PG8_SB(0, 1), cB + hstep, voffB); PG8_STAGE(PG8_SA(0, 0), cA, voffA); PG8_STAGE(PG8_SA(0, 1), cA + hstep, voffA);
        if (wr == 1) PG8_BAR;
        PG8_WAIT_V(2); PG8_BAR;
        PG8_STAGE(PG8_SB(1, 0), cB + kstep, voffB); PG8_STAGE(PG8_SA(1, 0), cA + kstep, voffA); PG8_STAGE(PG8_SB(1, 1), cB + hstep + kstep, voffB);
        PG8_WAIT_V(6); PG8_BAR;
    } else {
        PG8_STAGE(PG8_SB(0, 0), cB, voffB); PG8_STAGE(PG8_SA(0, 0), cA, voffA); PG8_STAGE(PG8_SB(0, 1), cB + hstep, voffB); PG8_STAGE(PG8_SA(0, 1), cA + hstep, voffA);
        if (wr == 1) PG8_BAR;
        PG8_WAIT_V(4); PG8_BAR;
        PG8_STAGE(PG8_SB(1, 0), cB + kstep, voffB); PG8_STAGE(PG8_SA(1, 0), cA + kstep, voffA); PG8_STAGE(PG8_SB(1, 1), cB + hstep + kstep, voffB);
        PG8_WAIT_V(6); PG8_BAR;
    }
    for (;;) {
        const bool has_next = S.next(ui + 1, nxt);
        const char* nA = has_next ? (const char*)g.A + (size_t)nxt.pm * tstep : cA; const char* nB = has_next ? (const char*)g.Bt + (size_t)nxt.pn * tstep : cB;
        for (int t = 0; t < nt; t += 2) {
            const bool last = (t == nt - 2);
            const char* a1 = cA + (size_t)(t + 1) * kstep;
            const char* a2 = last ? nA : cA + (size_t)(t + 2) * kstep; const char* b2 = last ? nB : cB + (size_t)(t + 2) * kstep;
            const char* a3 = a2 + kstep; const char* b3 = b2 + kstep;
            if (last && has_next) S.a_ready(nxt);
            if constexpr (SP2) {
            PG8_LDB(B0, 0, 0); PG8_LDB(B1, 0, 1); PG8_SCHED; PG8_LDA(At, 0, 0); PG8_STAGE(PG8_SA(1, 1), a1 + hstep, voffA);
            PG8_WAIT_V(8); PG8_WAIT_L(0); PG8_BAR; PG8_MMA(0, 0, At, B0); PG8_MMA(0, 1, At, B1); PG8_BAR; PG8_SCHED;
            PG8_LDA(At, 0, 1); PG8_STAGE(PG8_SB(0, 0), b2, voffB); PG8_STAGE(PG8_SB(0, 1), b2 + hstep, voffB); PG8_STAGE(PG8_SA(0, 0), a2, voffA);
            PG8_WAIT_V(8); PG8_WAIT_L(0); PG8_BAR; PG8_MMA(1, 0, At, B0); PG8_MMA(1, 1, At, B1); PG8_BAR; PG8_SCHED;
            PG8_LDB(B0, 1, 0); PG8_LDB(B1, 1, 1); PG8_SCHED; PG8_LDA(At, 1, 0); PG8_STAGE(PG8_SA(0, 1), a2 + hstep, voffA);
            PG8_WAIT_V(8); PG8_WAIT_L(0); PG8_BAR; PG8_MMA(0, 0, At, B0); PG8_MMA(0, 1, At, B1); PG8_BAR; PG8_SCHED;
            PG8_LDA(At, 1, 1); PG8_STAGE(PG8_SB(1, 0), b3, voffB); PG8_STAGE(PG8_SB(1, 1), b3 + hstep, voffB); PG8_STAGE(PG8_SA(1, 0), a3, voffA);
            PG8_WAIT_V(8); PG8_WAIT_L(0); PG8_BAR; PG8_MMA(1, 0, At, B0); PG8_MMA(1, 1, At, B1); PG8_BAR; PG8_SCHED;
            } else {
            PG8_LDB(B0, 0, 0); PG8_SCHED; PG8_LDA(At, 0, 0); PG8_STAGE(PG8_SA(1, 1), a1 + hstep, voffA);
            PG8_WAIT_L(8); PG8_BAR; PG8_WAIT_L(0); PG8_MMA(0, 0, At, B0); PG8_BAR; PG8_SCHED;
            PG8_LDB(B1, 0, 1); PG8_STAGE(PG8_SB(0, 0), b2, voffB);
            PG8_BAR; PG8_WAIT_L(0); PG8_MMA(0, 1, At, B1); PG8_BAR;
            PG8_LDA(At, 0, 1); PG8_STAGE(PG8_SA(0, 0), a2, voffA);
            PG8_BAR; PG8_WAIT_L(0); PG8_MMA(1, 0, At, B0); PG8_BAR; PG8_SCHED;
            PG8_STAGE(PG8_SB(0, 1), b2 + hstep, voffB);
            PG8_WAIT_V(6); PG8_BAR; PG8_MMA(1, 1, At, B1); PG8_BAR;
            PG8_LDB(B0, 1, 0); PG8_SCHED; PG8_LDA(At, 1, 0); PG8_STAGE(PG8_SA(0, 1), a2 + hstep, voffA);
            PG8_WAIT_L(8); PG8_BAR; PG8_WAIT_L(0); PG8_MMA(0, 0, At, B0); PG8_BAR; PG8_SCHED;
            PG8_LDB(B1, 1, 1); PG8_STAGE(PG8_SB(1, 0), b3, voffB);
            PG8_BAR; PG8_WAIT_L(0); PG8_MMA(0, 1, At, B1); PG8_BAR;
            PG8_LDA(At, 1, 1); PG8_STAGE(PG8_SA(1, 0), a3, voffA);
            PG8_BAR; PG8_WAIT_L(0); PG8_MMA(1, 0, At, B0); PG8_BAR; PG8_SCHED;
            PG8_STAGE(PG8_SB(1, 1), b3 + hstep, voffB);
            PG8_WAIT_V(6); PG8_BAR; PG8_MMA(1, 1, At, B1); PG8_BAR;
            }
        }
        if constexpr (ALIGN_EPI) { if (wr == 0) PG8_BAR; }
        if constexpr (!Epi::AFTER_DRAIN) { E(acc, cur, wr, wc, fr, fq); S.done(cur); }
        if (!has_next) break;
#pragma unroll
        for (int a = 0; a < 2; ++a)
#pragma unroll
            for (int b = 0; b < 2; ++b)
#pragma unroll
                for (int m = 0; m < 4; ++m)
#pragma unroll
                    for (int n = 0; n < 2; ++n) acc[a][b][m][n] = (f32x4){0.f, 0.f, 0.f, 0.f};
        cur = nxt; cA = nA; cB = nB; ++ui;
        if constexpr (ALIGN_EPI) { if (wr == 1) PG8_BAR; }
    }
    PG8_WAIT_V(0);
    if constexpr (!ALIGN_EPI) { if (wr == 0) PG8_BAR; }
    PG8_BAR;
    if constexpr (Epi::AFTER_DRAIN) { E.fused(acc, cur, wr, wc, fr, fq, lds, wid, lane); S.done(cur); }
#undef PG8_SA
#undef PG8_SB
#undef PG8_STAGE
#undef PG8_LDA
#undef PG8_LDB
#undef PG8_MMA
#undef PG8_WAIT_V
#undef PG8_WAIT_L
#undef PG8_BAR
#undef PG8_SCHED
}
}
#ifndef PG8_SP2
#define PG8_SP2 true
#endif
#ifndef PG8_ALIGN
#define PG8_ALIGN true
#endif
#ifndef MK_PER_PHASE
#define MK_PER_PHASE 0
#endif

constexpr int DM = 2048, DFF = 5632, NMOD = 9, DEPTH = 4;
constexpr int NP_B = 32, NP_L = 256, NS_B = 2, NS_L = 4096, PAST = 512;
constexpr int TP = NP_B * NP_L, TS = NS_B * NS_L, T = TP + TS;
constexpr int HALFW = 1024;
constexpr int S5_G = 64, S5_H = 16, S5_P = 64;
constexpr int HY_EMB = 33, HY_FFN = 64, HY_BANDS = 16;
constexpr int RG_NB = 16, RG_BW = 64;
constexpr int NA_H = 16, NA_HD = 64, GRID_W = 64, GRID_R = 64, WIN_R = 8, WIN_C = 16;
constexpr int EVEN_IN = 4096, ODD_IN = 5120;
constexpr int ODD_LD = 4096;
constexpr float EPS = 1e-6f;
constexpr int NWAVES = 8, NTHR = 512;

constexpr size_t MiB = 1u << 20;
constexpr size_t WS_CTL = 0, CTL_ZERO_BYTES = 1 * MiB;
constexpr size_t WS_MODP = 1 * MiB;
constexpr size_t WS_MOD  = 9 * MiB;
constexpr size_t WS_S5A  = 10 * MiB;
constexpr size_t WS_S5BB = 11 * MiB;
constexpr size_t WS_HYNP = 24 * MiB;
constexpr size_t WS_HYIN = 28 * MiB;
constexpr size_t WS_RGS  = 16 * MiB;
constexpr size_t WS_S5E  = 20 * MiB;
constexpr size_t WS_WGU  = 32 * MiB;
constexpr size_t WS_WD   = 384 * MiB;
constexpr size_t WS_WINE = 560 * MiB;
constexpr size_t WS_WINO = 592 * MiB;
constexpr size_t WS_WOUT = 632 * MiB;
constexpr size_t WS_WGLU = 664 * MiB;
constexpr size_t WS_KF   = 672 * MiB;
constexpr size_t KF_EI_BYTES = 68 * MiB, KF_SMALL_OFF = 64 * MiB;
constexpr size_t WS_H    = 808 * MiB;
constexpr size_t WS_A1   = 872 * MiB;
constexpr size_t WS_PROJ = 1048 * MiB;
constexpr size_t PROJT_OFF = 64 * MiB;
constexpr size_t WS_MIX  = 1368 * MiB;
constexpr size_t WS_Z    = 1432 * MiB;
constexpr size_t WS_DLT  = 1464 * MiB;
constexpr size_t WS_AB   = 1528 * MiB;
constexpr size_t WS_QN   = 1784 * MiB;
constexpr size_t WS_VT   = 1816 * MiB;
constexpr size_t WS_KN   = 1848 * MiB;
constexpr size_t WS_CKB  = 1912 * MiB;
constexpr size_t WS_CVT  = 1916 * MiB;
constexpr size_t WS_H2T  = 1920 * MiB;
constexpr size_t WS_WGF  = 1924 * MiB;
constexpr size_t WS_XB   = 1925 * MiB;
constexpr size_t WS_END  = 1989 * MiB;
constexpr int CW_BAR = 4096;

constexpr size_t OUT_YP = 0, OUT_YS = (size_t)TP * DM, OUT_NAK = (size_t)T * DM;
constexpr size_t OUT_NAV = OUT_NAK + (size_t)NP_B * 2 * NP_L * 1024;
constexpr size_t OUT_S5 = OUT_NAV + (size_t)NP_B * 2 * NP_L * 1024;
constexpr size_t OUT_RG = OUT_S5 + (size_t)NP_B * 2 * 2 * 64 * 64 * 2;
constexpr size_t OUT_END = OUT_RG + (size_t)NP_B * 2 * 2 * 1024;

constexpr int RING_OFF = 0, RING_BYTES = 131072;
constexpr int LDSCTL_OFF = RING_BYTES, MISC_OFF = LDSCTL_OFF + 320;
constexpr int LDS_BYTES = 147456;

#define GAS __attribute__((address_space(1)))
#define LAS __attribute__((address_space(3)))
typedef unsigned short bf16;
typedef unsigned v4u __attribute__((ext_vector_type(4)));
typedef unsigned v2u __attribute__((ext_vector_type(2)));
typedef float f32x4 __attribute__((ext_vector_type(4)));
typedef float f32x2 __attribute__((ext_vector_type(2)));
typedef short bf16x8 __attribute__((ext_vector_type(8)));
typedef GAS unsigned gu32;
#define RLX_AGENT __ATOMIC_RELAXED, __HIP_MEMORY_SCOPE_AGENT
#define LDS_WAIT() asm volatile("s_waitcnt lgkmcnt(0)" ::: "memory")
#define VM_WAIT() asm volatile("s_waitcnt vmcnt(0)" ::: "memory")
__device__ __forceinline__ unsigned pk2(float lo, float hi) { return pg8::cvt_pk_bf16(lo, hi); }
__device__ __forceinline__ unsigned f2bf(float f) { return pk2(f, 0.f) & 0xffffu; }
__device__ __forceinline__ float bf2f(unsigned short b) { return __uint_as_float(((unsigned)b) << 16); }
__device__ __forceinline__ float sigmoidf_(float x) { return __builtin_amdgcn_rcpf(1.0f + __expf(-x)); }
__device__ __forceinline__ float siluf_(float x) { return x * sigmoidf_(x); }
__device__ __forceinline__ float gelu_tanh(float x) { const float u = 0.7978845608028654f * (x + 0.044715f * x * x * x); return x * sigmoidf_(2.0f * u); }
__device__ __forceinline__ float wave_sum(float v) {
#pragma unroll
    for (int o = 1; o < 64; o <<= 1) v += __shfl_xor(v, o);
    return v;
}
__device__ __forceinline__ float wave_max(float v) {
#pragma unroll
    for (int o = 1; o < 64; o <<= 1) v = fmaxf(v, __shfl_xor(v, o));
    return v;
}

#define XB_TMO      128
#define XB_XCNT(j)  (256  + 64 * (j))
#define XB_XSUB(j)  (1280 + 64 * (j))
#define XB_XGEN(j)  (2304 + 64 * (j))
#define XB_TOP      3328
#define XB_TOPGEN   3392
#define XCD_BAR_WORDS 3456
#define XB_SPIN_CAP (1u << 18)
__device__ __forceinline__ unsigned xb_ld(unsigned* p)              { return __hip_atomic_load(p, __ATOMIC_RELAXED, __HIP_MEMORY_SCOPE_AGENT); }
__device__ __forceinline__ unsigned xb_add(unsigned* p, unsigned v) { return __hip_atomic_fetch_add(p, v, __ATOMIC_RELAXED, __HIP_MEMORY_SCOPE_AGENT); }
__device__ __forceinline__ unsigned xb_xcc_id() { return (unsigned)__builtin_amdgcn_s_getreg((3 << 11) | 20) & 0xFu; }
#define XB_SPIN(cond, bar) do { unsigned _sp = 0; while (cond) { __builtin_amdgcn_s_sleep(1); \
    if ((++_sp & 255u) == 0u) { if (xb_ld(&(bar)[XB_TMO])) break; if (_sp > XB_SPIN_CAP) { atomicAdd(&(bar)[XB_TMO], 1u); break; } } } } while (0)
struct XcdBarrier { unsigned* bar; unsigned x; volatile LAS unsigned* st; };
__device__ __forceinline__ XcdBarrier xcd_barrier_post(unsigned* bar, volatile LAS unsigned* st) {
    XcdBarrier b; b.bar = bar; b.x = xb_xcc_id(); b.st = st;
    if (threadIdx.x == 0) (void)xb_add(&bar[XB_XCNT(b.x)], 1u);
    return b;
}
__device__ __forceinline__ void xcd_barrier_complete(unsigned* bar, unsigned x, unsigned& nloc, unsigned& nx) {
    const unsigned G = gridDim.x * gridDim.y * gridDim.z;
    unsigned sum, cnt, mine, sp = 0u;
    for (;;) {
        sum = 0u; cnt = 0u; mine = 0u;
#pragma unroll
        for (unsigned j = 0; j < 16; ++j) { const unsigned c = xb_ld(&bar[XB_XCNT(j)]); sum += c; cnt += (c > 0u) ? 1u : 0u; mine = (j == x) ? c : mine; }
        if (sum == G) break;
        __builtin_amdgcn_s_sleep(1);
        if ((++sp & 255u) == 0u) { if (xb_ld(&bar[XB_TMO])) break; if (sp > XB_SPIN_CAP) { atomicAdd(&bar[XB_TMO], 1u); break; } }
    }
    nloc = mine > 0u ? mine : 1u; nx = cnt > 0u ? cnt : 1u;
}
__device__ __forceinline__ void xcd_barrier(const XcdBarrier& b) {
    asm volatile("s_waitcnt vmcnt(0)" ::: "memory");
    __syncthreads();
    if (threadIdx.x == 0) {
        unsigned* bar = b.bar; unsigned bx = b.x;
        asm volatile("" : "+s"(bar), "+s"(bx));
        __builtin_amdgcn_s_waitcnt(0);
        unsigned nloc = b.st[0], nx = b.st[1];
        if (nloc == 0u) { xcd_barrier_complete(bar, bx, nloc, nx); b.st[0] = nloc; b.st[1] = nx; }
        const unsigned old = xb_add(&bar[XB_XSUB(bx)], 1u);
        const unsigned gen = old / nloc;
        if (old + 1u == (gen + 1u) * nloc) {
            __builtin_amdgcn_fence(__ATOMIC_RELEASE, "agent");
            asm volatile("s_waitcnt vmcnt(0)" ::: "memory");
            const unsigned og = xb_add(&bar[XB_TOP], 1u);
            const unsigned tg = og / nx;
            if (og + 1u == (tg + 1u) * nx) xb_add(&bar[XB_TOPGEN], 1u);
            else XB_SPIN(xb_ld(&bar[XB_TOPGEN]) == tg, bar);
            __builtin_amdgcn_fence(__ATOMIC_ACQUIRE, "agent");
            xb_add(&bar[XB_XGEN(bx)], 1u);
            asm volatile("s_waitcnt vmcnt(0)" ::: "memory");
        } else {
            XB_SPIN(xb_ld(&bar[XB_XGEN(bx)]) == gen, bar);
            __builtin_amdgcn_fence(__ATOMIC_ACQUIRE, "agent");
            asm volatile("s_waitcnt vmcnt(0)" ::: "memory");
        }
    }
    __syncthreads();
}

struct Frame {
    LAS unsigned char* lds;
    int tid, lane, wave;
    int vcu, G;
    int gw, NGW;
};
enum { I_XP = 0, I_XS, I_CK, I_CV, I_SS5, I_SRG, I_C, I_CCTX, I_NG, I_MODW, I_MODB, I_WG, I_WU, I_WD, I_EWIN, I_EWOUT,
       I_S5LRE, I_S5LIM, I_S5LDT, I_S5BRE, I_S5BIM, I_S5CRE, I_S5CIM, I_S5D, I_S5GLUW, I_S5GLUB,
       I_HYCW, I_HYCB, I_HYW1, I_HYB1, I_HYW2, I_HYB2, I_HYW3, I_HYFREQ, I_HYDEC, I_HYBIAS,
       I_OWIN, I_OWOUT, I_RGCW, I_RGCB, I_RGWA, I_RGBA, I_RGWI, I_RGBI, I_RGLAM, I_NAQN, I_NAKN, I_NARPB, N_IN };
struct Args { const float* in[N_IN]; float* out; unsigned char* ws; int ph_lo, ph_hi; };

__device__ __forceinline__ int seq_row0(int sq) { return sq < NP_B ? sq * NP_L : TP + (sq - NP_B) * NS_L; }
__device__ __forceinline__ int seq_len(int sq) { return sq < NP_B ? NP_L : NS_L; }
__device__ __forceinline__ int row_cond(int row) { return row < TP ? 0 : (row < TP + NS_L ? 1 : 2); }
__device__ __forceinline__ void p0_transpose_item(const float* W, int K, int N, bf16* WT, int mode, LAS float* scr, int item, int lane) {
    const int nblk = N / 32, kb = item / nblk, nb = item % nblk, k0 = 64 * kb, n0 = 32 * nb;
#pragma unroll 8
    for (int i = 0; i < 32; ++i) { const int kk = 2 * i + (lane >> 5); scr[kk * 33 + (lane & 31)] = W[(size_t)(k0 + kk) * N + n0 + (lane & 31)]; }
    LDS_WAIT(); asm volatile("" ::: "memory");
    const int c = lane & 7;
    const int rbase = (mode == 0) ? n0 : ((n0 >> 7) * 256 + (n0 & 127) + (mode == 2 ? 128 : 0));
#pragma unroll
    for (int j = 0; j < 4; ++j) { const int n = (lane >> 3) + 8 * j; const LAS float* s = scr + (8 * c) * 33 + n;
        v4u o; o.x = pk2(s[0 * 33], s[1 * 33]); o.y = pk2(s[2 * 33], s[3 * 33]); o.z = pk2(s[4 * 33], s[5 * 33]); o.w = pk2(s[6 * 33], s[7 * 33]);
        *(GAS v4u*)(WT + (size_t)(rbase + n) * K + k0 + 8 * c) = o; }
    LDS_WAIT(); asm volatile("" ::: "memory");
}

__device__ __forceinline__ void p0_weights(const Args& a, Frame& F) {
    LAS float* scr = (LAS float*)(F.lds + RING_OFF + F.wave * 16384);
    unsigned char* ws = a.ws;
    constexpr int IT_F = 5632;
    constexpr int N_FFN = 24 * IT_F;
    constexpr int IT_EIN = 32 * 128, IT_OIN = 32 * 160, IT_OUT = 32 * 64, IT_GLU = 16 * 32;
    constexpr int IT_CV = (PAST / 64) * (1024 / 32);
    constexpr int NITEMS = N_FFN + 2 * (IT_EIN + IT_OIN + 2 * IT_OUT + IT_GLU) + 4 * IT_CV;
    for (int it = F.gw; it < NITEMS; it += F.NGW) {
        int r = it;
        if (r < N_FFN) {
            const int mi = r / IT_F, li = r % IT_F;
            if (mi < 8)       p0_transpose_item(a.in[I_WG] + (size_t)mi * DM * DFF, DM, DFF, (bf16*)(ws + WS_WGU) + (size_t)mi * 2 * DFF * DM, 1, scr, li, F.lane);
            else if (mi < 16) p0_transpose_item(a.in[I_WU] + (size_t)(mi - 8) * DM * DFF, DM, DFF, (bf16*)(ws + WS_WGU) + (size_t)(mi - 8) * 2 * DFF * DM, 2, scr, li, F.lane);
            else              p0_transpose_item(a.in[I_WD] + (size_t)(mi - 16) * DFF * DM, DFF, DM, (bf16*)(ws + WS_WD) + (size_t)(mi - 16) * DM * DFF, 0, scr, li, F.lane);
            continue;
        }
        r -= N_FFN;
        if (r < 2 * IT_EIN) { const int e = r / IT_EIN; p0_transpose_item(a.in[I_EWIN] + (size_t)e * DM * EVEN_IN, DM, EVEN_IN, (bf16*)(ws + WS_WINE) + (size_t)e * EVEN_IN * DM, 0, scr, r % IT_EIN, F.lane); continue; }
        r -= 2 * IT_EIN;
        if (r < 2 * IT_OIN) { const int e = r / IT_OIN; p0_transpose_item(a.in[I_OWIN] + (size_t)e * DM * ODD_IN, DM, ODD_IN, (bf16*)(ws + WS_WINO) + (size_t)e * ODD_IN * DM, 0, scr, r % IT_OIN, F.lane); continue; }
        r -= 2 * IT_OIN;
        if (r < 2 * IT_OUT) { const int e = r / IT_OUT; p0_transpose_item(a.in[I_EWOUT] + (size_t)e * DM * DM, DM, DM, (bf16*)(ws + WS_WOUT) + (size_t)(2 * e) * DM * DM, 0, scr, r % IT_OUT, F.lane); continue; }
        r -= 2 * IT_OUT;
        if (r < 2 * IT_OUT) { const int e = r / IT_OUT; p0_transpose_item(a.in[I_OWOUT] + (size_t)e * DM * DM, DM, DM, (bf16*)(ws + WS_WOUT) + (size_t)(2 * e + 1) * DM * DM, 0, scr, r % IT_OUT, F.lane); continue; }
        r -= 2 * IT_OUT;
        if (r < 2 * IT_GLU) { const int e = r / IT_GLU; p0_transpose_item(a.in[I_S5GLUW] + (size_t)e * HALFW * HALFW, HALFW, HALFW, (bf16*)(ws + WS_WGLU) + (size_t)e * HALFW * HALFW, 0, scr, r % IT_GLU, F.lane); continue; }
        r -= 2 * IT_GLU;
        { const int e = r / IT_CV; p0_transpose_item(a.in[I_CV] + (size_t)e * PAST * 1024, PAST, 1024, (bf16*)(ws + WS_CVT) + (size_t)e * 1024 * PAST, 0, scr, r % IT_CV, F.lane); }
    }
}

__device__ __forceinline__ void p0_cache_k(const Args& a, Frame& F) {
    const GAS f32x4* src = (const GAS f32x4*)a.in[I_CK]; GAS v2u* dst = (GAS v2u*)(a.ws + WS_CKB);
    for (int i = F.vcu * NTHR + F.tid; i < NS_B * 2 * PAST * 1024 / 4; i += F.G * NTHR) { const f32x4 v = src[i]; v2u w; w.x = pk2(v.x, v.y); w.y = pk2(v.z, v.w); dst[i] = w; }
}
__device__ __forceinline__ void p0_gate_frags(const Args& a, Frame& F) {
    GAS v4u* dst = (GAS v4u*)(a.ws + WS_WGF);
    for (int i = F.vcu * NTHR + F.tid; i < 2 * 2 * 2 * RG_NB * 2 * 4 * 64; i += F.G * NTHR) {
        const int lane = i & 63, ks = (i >> 6) & 3, nt = (i >> 8) & 1, nb = (i >> 9) & 15, gate = (i >> 13) & 1, od = i >> 14;
        const float* w = (gate ? a.in[I_RGWI] : a.in[I_RGWA]) + ((size_t)(od * RG_NB + nb)) * 4096 + (16 * ks + 8 * (lane >> 5)) * 64 + 32 * nt + (lane & 31);
        v4u o; o.x = pk2(w[0], w[64]); o.y = pk2(w[128], w[192]); o.z = pk2(w[256], w[320]); o.w = pk2(w[384], w[448]);
        dst[i] = o;
    }
}
__device__ __forceinline__ void p0_copy_x(const Args& a, Frame& F) {
    const size_t n4 = (size_t)T * DM / 4, np4 = (size_t)TP * DM / 4;
    const GAS f32x4* xp = (const GAS f32x4*)a.in[I_XP]; const GAS f32x4* xs = (const GAS f32x4*)a.in[I_XS]; GAS f32x4* o = (GAS f32x4*)a.out;
    for (size_t i = (size_t)F.vcu * NTHR + F.tid; i < n4; i += (size_t)F.G * NTHR) o[i] = i < np4 ? xp[i] : xs[i - np4];
}

__device__ __forceinline__ void p0_adaln(const Args& a, Frame& F) {
    LAS float* scr = (LAS float*)(F.lds + RING_OFF + F.wave * 16384);
    const float* modw = a.in[I_MODW]; float* modp = (float*)(a.ws + WS_MODP);
    constexpr int NC = NMOD * DM;
    for (int it = F.gw; it < 4 * 72 * 8; it += F.NGW) {
        const int li = it / 576, r0 = it % 576, cc = r0 / 8, ks = r0 % 8, k0 = ks * 256, col = cc * 256 + F.lane * 4;
#pragma unroll
        for (int q = 0; q < 4; ++q) { const int k = k0 + F.lane + 64 * q;
            scr[F.lane + 64 * q] = siluf_(a.in[I_CCTX][k]); scr[256 + F.lane + 64 * q] = siluf_(a.in[I_C][k]); scr[512 + F.lane + 64 * q] = siluf_(a.in[I_C][DM + k]); }
        LDS_WAIT(); asm volatile("" ::: "memory");
        f32x4 a0 = {0.f, 0.f, 0.f, 0.f}, a1 = a0, a2 = a0;
        const float* wp = modw + ((size_t)li * DM + k0) * NC + col;
#pragma unroll 8
        for (int k = 0; k < 256; ++k) { const f32x4 w = *(const GAS f32x4*)(wp + (size_t)k * NC); a0 += scr[k] * w; a1 += scr[256 + k] * w; a2 += scr[512 + k] * w; }
        float* dst = modp + ((size_t)(ks * 4 + li) * 3) * NC + col;
        *(GAS f32x4*)(dst) = a0; *(GAS f32x4*)(dst + NC) = a1; *(GAS f32x4*)(dst + 2 * NC) = a2;
        LDS_WAIT(); asm volatile("" ::: "memory");
    }
}
__device__ __forceinline__ void p0b_adaln_final(const Args& a, Frame& F) {
    constexpr int NC = NMOD * DM, NTOT = 4 * 3 * NC;
    const float* modp = (const float*)(a.ws + WS_MODP); float* mod = (float*)(a.ws + WS_MOD);
    for (int i = (F.vcu * NTHR + F.tid) * 4; i < NTOT; i += F.G * NTHR * 4) {
        const int li = i / (3 * NC), j = i % NC;
        f32x4 s = *(const GAS f32x4*)(a.in[I_MODB] + (size_t)li * NC + j);
#pragma unroll
        for (int ks = 0; ks < 8; ++ks) s += *(const GAS f32x4*)(modp + (size_t)ks * NTOT + i);
        const int m = j / DM;
        if (m % 3 == 1) { const f32x4 gg = *(const GAS f32x4*)(a.in[I_NG] + ((size_t)li * 3 + m / 3) * DM + (j % DM)); s = gg * (s + 1.0f); }
        *(GAS f32x4*)(mod + i) = s;
    }
}

__device__ __forceinline__ void p0_s5params(const Args& a, Frame& F) {
    float* SA = (float*)(a.ws + WS_S5A); float* SBB = (float*)(a.ws + WS_S5BB);
    for (int i = F.vcu * NTHR + F.tid; i < 2 * 2 * S5_G * S5_P; i += F.G * NTHR) {
        const int edg = i / S5_P;
        const float lr = fminf(a.in[I_S5LRE][i], -1e-4f), li = a.in[I_S5LIM][i], dt = expf(a.in[I_S5LDT][edg]);
        const float mag = expf(lr * dt), abr = mag * cosf(li * dt), abi = mag * sinf(li * dt);
        const float den = lr * lr + li * li;
        const float cr = ((abr - 1.0f) * lr + abi * li) / den, ci = (abi * lr - (abr - 1.0f) * li) / den;
        SA[2 * i] = abr; SA[2 * i + 1] = abi;
#pragma unroll 4
        for (int h = 0; h < S5_H; ++h) { const float br = a.in[I_S5BRE][(size_t)i * S5_H + h], bi = a.in[I_S5BIM][(size_t)i * S5_H + h];
            SBB[((size_t)i * S5_H + h) * 2] = cr * br - ci * bi; SBB[((size_t)i * S5_H + h) * 2 + 1] = cr * bi + ci * br; }
    }
}

__device__ __forceinline__ void p0_hyena_h2(const Args& a, Frame& F) {
    LAS float* zs = (LAS float*)(F.lds + RING_OFF + F.wave * 16384);
    LAS float* h1r = zs + HY_EMB * 64;
    float* H2T = (float*)(a.ws + WS_H2T);
    for (int it = F.gw; it < 2 * 68; it += F.NGW) {
        const int ei = it / 68, ttg = it % 68;
        const int Lsel = ttg < 64 ? 0 : 1, tt = ttg < 64 ? ttg : ttg - 64, L = Lsel == 0 ? NS_L : NP_L;
        {   const int t = tt * 64 + F.lane; const float tf = (float)t;
            zs[F.lane] = tf / (float)L;
            const float cang = (float)(2.0 * 3.14159265358979323846 / (double)L) * tf;
#pragma unroll 4
            for (int b = 0; b < HY_BANDS; ++b) { const float band = 1e-4f + (float)b * ((15.0f - 1e-4f) / 15.0f); const float ang = cang * band; zs[(1 + b) * 64 + F.lane] = cosf(ang); zs[(17 + b) * 64 + F.lane] = -sinf(ang); }
        }
        const int j = F.lane;
        float w1c[HY_EMB], w2c[HY_FFN];
#pragma unroll
        for (int e = 0; e < HY_EMB; ++e) w1c[e] = a.in[I_HYW1][(size_t)ei * HY_EMB * HY_FFN + e * HY_FFN + j];
#pragma unroll
        for (int k = 0; k < HY_FFN; ++k) w2c[k] = a.in[I_HYW2][(size_t)ei * HY_FFN * HY_FFN + k * HY_FFN + j];
        const float b1j = a.in[I_HYB1][ei * HY_FFN + j], b2j = a.in[I_HYB2][ei * HY_FFN + j], frj = a.in[I_HYFREQ][ei * HY_FFN + j];
        float* dst = H2T + ((size_t)(ei * 2 + Lsel) * 64 + j) * 4096 + tt * 64;
        asm volatile("s_waitcnt lgkmcnt(0)" ::: "memory");
        for (int tl = 0; tl < 64; ++tl) {
            float s = b1j;
#pragma unroll
            for (int e = 0; e < HY_EMB; ++e) s += zs[e * 64 + tl] * w1c[e];
            asm volatile("" ::: "memory");
            h1r[j] = sinf(frj * s);
            asm volatile("s_waitcnt lgkmcnt(0)" ::: "memory");
            float s2 = b2j;
#pragma unroll
            for (int k4 = 0; k4 < 16; ++k4) { const f32x4 hv = ((const LAS f32x4*)h1r)[k4]; s2 += hv.x * w2c[4 * k4] + hv.y * w2c[4 * k4 + 1] + hv.z * w2c[4 * k4 + 2] + hv.w * w2c[4 * k4 + 3]; }
            asm volatile("s_waitcnt lgkmcnt(0)" ::: "memory");
            dst[tl] = sinf(frj * s2);
        }
        asm volatile("s_waitcnt lgkmcnt(0)" ::: "memory");
    }
}
typedef float f32x16p __attribute__((ext_vector_type(16)));
__device__ __forceinline__ void p0b_hyena_filters(const Args& a, Frame& F) {
    const float* H2T = (const float*)(a.ws + WS_H2T);
    const int l31 = F.lane & 31, hh = F.lane >> 5;
    for (int it = F.gw; it < 2 * 68 * 64; it += F.NGW) {
        const int ei = it / (68 * 64), r0 = it % (68 * 64), ttg = r0 / 64, ct = r0 % 64;
        const int Lsel = ttg < 64 ? 0 : 1, tt = ttg < 64 ? ttg : ttg - 64, L = Lsel == 0 ? NS_L : NP_L;
        const float* w3 = a.in[I_HYW3] + (size_t)ei * HY_FFN * 4096 + ct * 64; const float* dec = a.in[I_HYDEC] + (size_t)ei * 4096;
        const float* h2 = H2T + ((size_t)(ei * 2 + Lsel) * 64) * 4096 + tt * 64;
        f32x16p acc[2][2];
#pragma unroll
        for (int i = 0; i < 2; ++i)
#pragma unroll
            for (int j = 0; j < 2; ++j)
#pragma unroll
                for (int e = 0; e < 16; ++e) acc[i][j][e] = 0.f;
#pragma unroll 8
        for (int ks = 0; ks < 32; ++ks) {
            const int k = 2 * ks + hh;
            const float a0 = w3[(size_t)k * 4096 + l31], a1 = w3[(size_t)k * 4096 + 32 + l31];
            const float b0 = h2[(size_t)k * 4096 + l31], b1 = h2[(size_t)k * 4096 + 32 + l31];
            acc[0][0] = __builtin_amdgcn_mfma_f32_32x32x2f32(a0, b0, acc[0][0], 0, 0, 0);
            acc[0][1] = __builtin_amdgcn_mfma_f32_32x32x2f32(a0, b1, acc[0][1], 0, 0, 0);
            acc[1][0] = __builtin_amdgcn_mfma_f32_32x32x2f32(a1, b0, acc[1][0], 0, 0, 0);
            acc[1][1] = __builtin_amdgcn_mfma_f32_32x32x2f32(a1, b1, acc[1][1], 0, 0, 0);
        }
        bf16* kf = (bf16*)(a.ws + WS_KF + (size_t)ei * KF_EI_BYTES + (Lsel ? KF_SMALL_OFF : 0));
        float* np = (float*)(a.ws + WS_HYNP) + ((size_t)((ei * 2 + Lsel) * 64 + tt)) * 4096;
#pragma unroll
        for (int i = 0; i < 2; ++i)
#pragma unroll
            for (int e = 0; e < 16; ++e) {
                const int cg = ct * 64 + 32 * i + (e & 3) + 8 * (e >> 2) + 4 * hh, n = cg >> 11, dir = (cg >> 10) & 1, c = cg & 1023;
                const float dk = fabsf(dec[cg]);
                bf16* kp = kf + ((size_t)(n * 1024 + c)) * (2 * L);
                float sabs = 0.f;
#pragma unroll
                for (int j = 0; j < 2; ++j) { const int t = tt * 64 + 32 * j + l31;
                    float v = acc[i][j][e] * expf(-((float)t / (float)L) * dk);
                    if (dir == 0) kp[L - 1 - t] = (bf16)f2bf(v); else { if (t == 0) { kp[2 * L - 1] = 0; v = 0.f; } else kp[L - 1 + t] = (bf16)f2bf(v); }
                    sabs += fabsf(v); }
                sabs += __shfl_xor(sabs, 1); sabs += __shfl_xor(sabs, 2); sabs += __shfl_xor(sabs, 4); sabs += __shfl_xor(sabs, 8); sabs += __shfl_xor(sabs, 16);
                if (l31 == 0) np[cg] = sabs;
            }
    }
}
__device__ __forceinline__ void p0b_hyena_norm(const Args& a, Frame& F) {
    const float* np = (const float*)(a.ws + WS_HYNP); float* inv = (float*)(a.ws + WS_HYIN);
    for (int i = F.vcu * NTHR + F.tid; i < 2 * 2 * 2 * 1024; i += F.G * NTHR) {
        const int el = i >> 11, n = (i >> 10) & 1, c = i & 1023, ntt = (el & 1) ? 4 : 64;
        float s = 0.f;
        for (int tt = 0; tt < ntt; ++tt) { const float* p = np + ((size_t)(el * 64 + tt)) * 4096 + (n * 2) * 1024 + c; s += p[0] + p[1024]; }
        inv[i] = 1.0f / s;
    }
}
__device__ __forceinline__ void phase_norm(const Args& a, Frame& F, const float* g, const float* shift, const float* scale, bool first) {
    bf16* Xb = (bf16*)(a.ws + WS_XB); bf16* H = (bf16*)(a.ws + WS_H);
    for (int row0 = 2 * F.gw; row0 < T; row0 += 2 * F.NGW) {
        f32x4 v[2][8];
#pragma unroll
        for (int u = 0; u < 2; ++u) { const int row = min(row0 + u, T - 1);
            GAS v2u* xb = (GAS v2u*)(Xb + (size_t)row * DM) + F.lane;
            if (first) { const GAS f32x4* xr = (const GAS f32x4*)((row < TP ? a.in[I_XP] + (size_t)row * DM : a.in[I_XS] + (size_t)(row - TP) * DM)) + F.lane;
#pragma unroll
                for (int j = 0; j < 8; ++j) v[u][j] = xr[64 * j]; }
            else {
#pragma unroll
                for (int j = 0; j < 8; ++j) { const v2u x = xb[64 * j];
                    v[u][j].x = __uint_as_float(x.x << 16); v[u][j].y = __uint_as_float(x.x & 0xffff0000u); v[u][j].z = __uint_as_float(x.y << 16); v[u][j].w = __uint_as_float(x.y & 0xffff0000u); } } }
#pragma unroll
        for (int u = 0; u < 2; ++u) { const int row = row0 + u;
            if (row < T) {
                const int cond = row_cond(row);
                GAS v2u* xb = (GAS v2u*)(Xb + (size_t)row * DM) + F.lane;
                if (first) {
#pragma unroll
                    for (int j = 0; j < 8; ++j) { v2u w; w.x = pk2(v[u][j].x, v[u][j].y); w.y = pk2(v[u][j].z, v[u][j].w); xb[64 * j] = w; } }
                float ss = 0.f;
#pragma unroll
                for (int j = 0; j < 8; ++j) ss += (v[u][j].x * v[u][j].x + v[u][j].y * v[u][j].y) + (v[u][j].z * v[u][j].z + v[u][j].w * v[u][j].w);
                const float rstd = 1.0f / sqrtf(wave_sum(ss) * (1.0f / DM) + EPS);
                const float* sh = shift + (size_t)cond * NMOD * DM; const float* sc = scale + (size_t)cond * NMOD * DM;
                GAS v2u* o8 = (GAS v2u*)(H + (size_t)row * DM) + F.lane;
#pragma unroll
                for (int j = 0; j < 8; ++j) { const int col = (F.lane + 64 * j) * 4;
                    const f32x4 s1 = *(const GAS f32x4*)(sc + col), s0 = *(const GAS f32x4*)(sh + col);
                    const f32x4 y = (v[u][j] * rstd) * s1 + s0;
                    v2u w; w.x = pk2(y.x, y.y); w.y = pk2(y.z, y.w); o8[64 * j] = w; }
            }
        }
    }
}

typedef float f32x4s __attribute__((ext_vector_type(4)));
typedef short bf16x4v __attribute__((ext_vector_type(4)));
struct S5B { bf16x4v b[8]; };
__device__ __forceinline__ void s5_load_bfrags(S5B& B, const float* SBB, int pbase, int lane) {
    const int n = lane & 15, kg = lane >> 4;
#pragma unroll
    for (int nt = 0; nt < 8; ++nt) {
        const int nn = 16 * nt + n, p = nn & 63, im = nn >> 6;
        const float* src = SBB + ((size_t)(pbase + p) * S5_H + 4 * kg) * 2;
        const f32x4 s0 = *(const GAS f32x4*)src, s1 = *(const GAS f32x4*)(src + 4);
        v2u ww; ww.x = im ? pk2(s0[1], s0[3]) : pk2(s0[0], s0[2]);
        ww.y = im ? pk2(s1[1], s1[3]) : pk2(s1[0], s1[2]);
        B.b[nt] = __builtin_bit_cast(bf16x4v, ww);
    }
}
__device__ __forceinline__ v2u s5_load_u(const bf16* U, size_t urow0, int g, int lane) {
    return *(const GAS v2u*)(U + (urow0 + (lane & 15)) * HALFW + g * S5_H + 4 * (lane >> 4));
}
__device__ __forceinline__ void s5_bu_tile(const S5B& B, const v2u wh, LAS float* bu, int lane) {
    const int r = lane & 15, kg = lane >> 4;
    const bf16x4v a1 = __builtin_bit_cast(bf16x4v, wh);
#pragma unroll
    for (int nt = 0; nt < 8; ++nt) {
        f32x4s acc = {0.f, 0.f, 0.f, 0.f};
        acc = __builtin_amdgcn_mfma_f32_16x16x16bf16_1k(a1, B.b[nt], acc, 0, 0, 0);
#pragma unroll
        for (int e = 0; e < 4; ++e) bu[(4 * kg + e) * 132 + 16 * nt + r] = acc[e];
    }
}
__device__ __forceinline__ void s5_pass1(const Args& a, Frame& F, int ei) {
    const bf16* U = (const bf16*)(a.ws + WS_PROJ);
    const float* SA = (const float*)(a.ws + WS_S5A); const float* SBB = (const float*)(a.ws + WS_S5BB); float* SE = (float*)(a.ws + WS_S5E);
    LAS float* bu = (LAS float*)(F.lds + RING_OFF + F.wave * 16384);
    for (int it = F.gw; it < 2 * 16 * 2 * S5_G; it += F.NGW) {
        const int g = it & 63, d = (it >> 6) & 1, c = (it >> 7) & 15, s = it >> 11;
        const int pbase = ((ei * 2 + d) * S5_G + g) * S5_P, pidx = pbase + F.lane;
        const float ar = SA[2 * pidx], ai = SA[2 * pidx + 1];
        S5B B; s5_load_bfrags(B, SBB, pbase, F.lane);
        const size_t row0 = (size_t)(TP + s * NS_L + c * 256);
        float hr = 0.f, hi = 0.f;
        v2u unext = s5_load_u(U, row0 + 16 * ((d == 0) ? 0 : 15), g, F.lane);
        for (int kb = 0; kb < 16; ++kb) {
            const v2u ucur = unext;
            if (kb + 1 < 16) unext = s5_load_u(U, row0 + 16 * ((d == 0) ? kb + 1 : 14 - kb), g, F.lane);
            s5_bu_tile(B, ucur, bu, F.lane);
            asm volatile("s_waitcnt lgkmcnt(0)" ::: "memory");
#pragma unroll
            for (int kk = 0; kk < 16; ++kk) { const int lr = (d == 0) ? kk : 15 - kk;
                const float br = bu[lr * 132 + F.lane], bi = bu[lr * 132 + 64 + F.lane];
                const float nr = ar * hr - ai * hi + br, ni = ar * hi + ai * hr + bi; hr = nr; hi = ni; }
            asm volatile("s_waitcnt lgkmcnt(0)" ::: "memory");
        }
        *(GAS f32x2*)(SE + ((size_t)it * S5_P + F.lane) * 2) = (f32x2){hr, hi};
    }
}
__device__ __forceinline__ void s5_pass2(const Args& a, Frame& F, int ei) {
    const bf16* U = (const bf16*)(a.ws + WS_PROJ);
    const float* SA = (const float*)(a.ws + WS_S5A); const float* SBB = (const float*)(a.ws + WS_S5BB); const float* SE = (const float*)(a.ws + WS_S5E);
    bf16* Z = (bf16*)(a.ws + WS_Z);
    LAS float* bu = (LAS float*)(F.lds + RING_OFF + F.wave * 16384);
    LAS unsigned short* hl = (LAS unsigned short*)(F.lds + RING_OFF + F.wave * 16384 + 8448);
    const int hq = F.lane & 15, kg = F.lane >> 4;
    for (int it = F.gw; it < 64 * S5_G; it += F.NGW) {
        const int g = it & 63, ch = it >> 6;
        const int row0 = ch * 256;
        f32x4s Y[16];
#pragma unroll
        for (int i = 0; i < 16; ++i) Y[i] = (f32x4s){0.f, 0.f, 0.f, 0.f};
#pragma unroll 1
        for (int d = 0; d < 2; ++d) {
            const int pbase = ((ei * 2 + d) * S5_G + g) * S5_P, pidx = pbase + F.lane;
            const float ar = SA[2 * pidx], ai = SA[2 * pidx + 1];
            S5B B; s5_load_bfrags(B, SBB, pbase, F.lane);
            bf16x8 cf[4];
            {   const size_t cb = ((size_t)((ei * 2 + d) * S5_G + g) * S5_H + hq) * S5_P;
#pragma unroll
                for (int ks = 0; ks < 4; ++ks) { const float* src = (ks < 2 ? a.in[I_S5CRE] : a.in[I_S5CIM]) + cb + (ks & 1) * 32 + 8 * kg; const float sg = ks < 2 ? 1.f : -1.f;
                    const f32x4 c0 = *(const GAS f32x4*)src, c1 = *(const GAS f32x4*)(src + 4);
                    v4u w; w.x = pk2(sg * c0.x, sg * c0.y); w.y = pk2(sg * c0.z, sg * c0.w); w.z = pk2(sg * c1.x, sg * c1.y); w.w = pk2(sg * c1.z, sg * c1.w); cf[ks] = __builtin_bit_cast(bf16x8, w); }
            }
            float hr = 0.f, hi = 0.f;
            if (ch >= 32) {
                const int s = (ch - 32) >> 4, c = (ch - 32) & 15;
                const f32x2 h0 = *(const GAS f32x2*)(a.in[I_SS5] + ((size_t)(((s * 2 + ei) * 2 + d) * S5_G + g) * S5_P + F.lane) * 2);
                hr = h0.x; hi = h0.y;
                float pr = ar, pi = ai;
#pragma unroll
                for (int q = 0; q < 8; ++q) { const float nr = pr * pr - pi * pi, ni = 2.f * pr * pi; pr = nr; pi = ni; }
                const int nfold = (d == 0) ? c : 15 - c;
#pragma unroll 8
                for (int q = 0; q < nfold; ++q) { const int cc = (d == 0) ? q : 15 - q;
                    const f32x2 e = *(const GAS f32x2*)(SE + ((size_t)((((s * 16 + cc) * 2 + d) * S5_G + g) * S5_P) + F.lane) * 2);
                    const float nr = pr * hr - pi * hi + e.x, ni = pr * hi + pi * hr + e.y; hr = nr; hi = ni; }
            }
            v2u unext = s5_load_u(U, (size_t)(row0 + 16 * ((d == 0) ? 0 : 15)), g, F.lane);
#pragma unroll
            for (int kb = 0; kb < 16; ++kb) {
                const v2u ucur = unext;
                if (kb + 1 < 16) unext = s5_load_u(U, (size_t)(row0 + 16 * ((d == 0) ? kb + 1 : 14 - kb)), g, F.lane);
                s5_bu_tile(B, ucur, bu, F.lane);
                asm volatile("s_waitcnt lgkmcnt(0)" ::: "memory");
#pragma unroll
                for (int kk = 0; kk < 16; ++kk) {
                    const int lr = (d == 0) ? kk : 15 - kk;
                    const float br = bu[lr * 132 + F.lane], bi = bu[lr * 132 + 64 + F.lane];
                    const float nr = ar * hr - ai * hi + br, ni = ar * hi + ai * hr + bi; hr = nr; hi = ni;
                    hl[lr * 136 + F.lane] = (bf16)f2bf(hr); hl[lr * 136 + 64 + F.lane] = (bf16)f2bf(hi);
                }
                asm volatile("s_waitcnt lgkmcnt(0)" ::: "memory");
                bf16x8 af[4];
#pragma unroll
                for (int ks = 0; ks < 4; ++ks) af[ks] = *(const LAS bf16x8*)(hl + hq * 136 + 32 * ks + 8 * kg);
                asm volatile("s_waitcnt lgkmcnt(0)" ::: "memory");
#pragma unroll
                for (int ks = 0; ks < 4; ++ks) {
                    if (d == 0) Y[kb] = __builtin_amdgcn_mfma_f32_16x16x32_bf16(af[ks], cf[ks], Y[kb], 0, 0, 0);
                    else Y[15 - kb] = __builtin_amdgcn_mfma_f32_16x16x32_bf16(af[ks], cf[ks], Y[15 - kb], 0, 0, 0);
                }
            }
            if (ch < 32) *(GAS f32x2*)(a.out + OUT_S5 + ((size_t)(((ch * 2 + ei) * 2 + d) * S5_G + g) * S5_P + F.lane) * 2) = (f32x2){hr, hi};
        }
        const float dsk = a.in[I_S5D][(ei * S5_G + g) * S5_H + hq];
#pragma unroll
        for (int i = 0; i < 16; ++i)
#pragma unroll
            for (int rg = 0; rg < 4; ++rg) { const size_t row = (size_t)(row0 + 16 * i + 4 * kg + rg);
                const float y = Y[i][rg] + dsk * bf2f(U[row * HALFW + g * S5_H + hq]);
                Z[row * HALFW + g * S5_H + hq] = (bf16)f2bf(gelu_tanh(y)); }
    }
}

typedef float f32x16 __attribute__((ext_vector_type(16)));
__device__ __forceinline__ void hyena_mfma_item(const Args& a, int ei, int rg, int c, LAS unsigned char* slab, int lane) {
    const int LB = rg < 2 ? 4 : 64, Lseq = 64 * LB, rowbase = rg * 4096;
    LAS unsigned short* zb = (LAS unsigned short*)slab;
    LAS unsigned char* cp = slab + 9216;
    const int r = lane & 31, h = lane >> 5;
    const bf16* PT = (const bf16*)(a.ws + WS_PROJ + PROJT_OFF);
    const float* cw = a.in[I_HYCW] + (size_t)ei * 3 * 3072; const float* cbv = a.in[I_HYCB] + (size_t)ei * 3072;
    const bf16* gf = (const bf16*)(a.ws + WS_KF + (size_t)ei * KF_EI_BYTES + (rg < 2 ? KF_SMALL_OFF : 0));
    const float* inv = (const float*)(a.ws + WS_HYIN) + (size_t)(ei * 2 + (rg < 2 ? 1 : 0)) * 2048;
    float zf[2][2][16];
    f32x16 acc[2][2];
#define HY_STAGE(x_, first_, invn_, bias_) do { \
        const bf16* prow_ = PT + (size_t)(x_) * T + rowbase; const float w0_ = cw[x_], w1_ = cw[3072 + (x_)], w2_ = cw[2 * 3072 + (x_)], cb_ = cbv[x_]; \
        _Pragma("unroll") for (int mt = 0; mt < 2; ++mt) _Pragma("unroll") for (int nt = 0; nt < 2; ++nt) _Pragma("unroll") for (int q = 0; q < 4; ++q) { \
            const int I_ = 32 * nt + r, j0_ = 32 * mt + 8 * q + 4 * h, t0_ = 64 * I_ + j0_, ts_ = t0_ & (Lseq - 1); \
            const v2u pw_ = *(const GAS v2u*)(prow_ + t0_); const f32x4 p_ = {__uint_as_float(pw_.x << 16), __uint_as_float(pw_.x & 0xffff0000u), __uint_as_float(pw_.y << 16), __uint_as_float(pw_.y & 0xffff0000u)}; \
            const float pm_ = ts_ > 0 ? bf2f(prow_[t0_ - 1]) : 0.f, pp_ = (ts_ + 4 < Lseq) ? bf2f(prow_[t0_ + 4]) : 0.f; \
            const float g0_ = cb_ + w0_ * pm_ + w1_ * p_.x + w2_ * p_.y, g1_ = cb_ + w0_ * p_.x + w1_ * p_.y + w2_ * p_.z, g2_ = cb_ + w0_ * p_.y + w1_ * p_.z + w2_ * p_.w, g3_ = cb_ + w0_ * p_.z + w1_ * p_.w + w2_ * pp_; \
            if (first_) { zf[mt][nt][4 * q] = g0_; zf[mt][nt][4 * q + 1] = g1_; zf[mt][nt][4 * q + 2] = g2_; zf[mt][nt][4 * q + 3] = g3_; } \
            else { zf[mt][nt][4 * q] = g0_ * (acc[mt][nt][4 * q] * (invn_) + (bias_) * zf[mt][nt][4 * q]); zf[mt][nt][4 * q + 1] = g1_ * (acc[mt][nt][4 * q + 1] * (invn_) + (bias_) * zf[mt][nt][4 * q + 1]); \
                   zf[mt][nt][4 * q + 2] = g2_ * (acc[mt][nt][4 * q + 2] * (invn_) + (bias_) * zf[mt][nt][4 * q + 2]); zf[mt][nt][4 * q + 3] = g3_ * (acc[mt][nt][4 * q + 3] * (invn_) + (bias_) * zf[mt][nt][4 * q + 3]); } \
            v2u w_; w_.x = pk2(zf[mt][nt][4 * q], zf[mt][nt][4 * q + 1]); w_.y = pk2(zf[mt][nt][4 * q + 2], zf[mt][nt][4 * q + 3]); \
            *(LAS v2u*)(zb + I_ * 72 + j0_) = w_; } } while (0)
    HY_STAGE(c, true, 0.f, 0.f);
    asm volatile("s_waitcnt lgkmcnt(0)" ::: "memory");
    const int rho = (r + 1) & 7;
    const int abase = rho * 272 + 2 * (8 * h - r + 63 + rho) - 64;
    for (int n = 0; n < 2; ++n) {
        const bf16* G = gf + ((size_t)(n * 1024 + c)) * (2 * Lseq);
#pragma unroll
        for (int mt = 0; mt < 2; ++mt)
#pragma unroll
            for (int nt = 0; nt < 2; ++nt)
#pragma unroll
                for (int e = 0; e < 16; ++e) acc[mt][nt][e] = 0.f;
        unsigned pair = ((const GAS unsigned*)(G + 64 * (2 * LB - 2)))[lane];
        for (int d = -(LB - 1); d < LB; ++d) {
            const unsigned cur = pair;
            if (d + 1 < LB) pair = ((const GAS unsigned*)(G + 64 * (LB - 2 - d)))[lane];
            const unsigned nxt = __shfl_down(cur, 1);
            const unsigned wodd = (cur >> 16) | (nxt << 16);
            asm volatile("" ::: "memory");
#pragma unroll
            for (int m = 0; m < 4; ++m) { ((LAS unsigned*)(cp + (2 * m) * 272))[lane + m] = cur; ((LAS unsigned*)(cp + (2 * m + 1) * 272))[lane + m + 1] = wodd; }
            asm volatile("" ::: "memory");
            bf16x8 A[2][4];
#pragma unroll
            for (int mt = 0; mt < 2; ++mt)
#pragma unroll
                for (int ks = 0; ks < 4; ++ks) A[mt][ks] = *(const LAS bf16x8*)(cp + abase + 32 * ks + 64 * (1 - mt));
#pragma unroll
            for (int nt = 0; nt < 2; ++nt) {
                const int I = 32 * nt + r, rel = (I & (LB - 1)) - d;
                const bool valid = (unsigned)rel < (unsigned)LB;
                if (__ballot(valid) == 0ull) continue;
                const LAS unsigned char* bp = (const LAS unsigned char*)zb + ((valid ? (I - d) : 0) * 72 + 8 * h) * 2;
                bf16x8 B[4];
#pragma unroll
                for (int ks = 0; ks < 4; ++ks) { const bf16x8 bv = *(const LAS bf16x8*)(bp + 32 * ks); B[ks] = valid ? bv : (bf16x8){0, 0, 0, 0, 0, 0, 0, 0}; }
#pragma unroll
                for (int mt = 0; mt < 2; ++mt)
#pragma unroll
                    for (int ks = 0; ks < 4; ++ks) acc[mt][nt] = __builtin_amdgcn_mfma_f32_32x32x16_bf16(A[mt][ks], B[ks], acc[mt][nt], 0, 0, 0);
            }
            asm volatile("" ::: "memory");
        }
        const int x = (1 + n) * 1024 + c;
        const float bias = a.in[I_HYBIAS][(size_t)(ei * 2 + n) * 1024 + c], invn = inv[n * 1024 + c];
        asm volatile("s_waitcnt lgkmcnt(0)" ::: "memory");
        HY_STAGE(x, false, invn, bias);
        asm volatile("s_waitcnt lgkmcnt(0)" ::: "memory");
    }
#undef HY_STAGE
}
__device__ __forceinline__ void hyena_store_block(const Args& a, Frame& F, int rowbase, int c0) {
    bf16* MIX = (bf16*)(a.ws + WS_MIX);
#pragma unroll
    for (int g = 0; g < 2; ++g) {
        const int t0 = (F.tid + g * NTHR) * 4, I = t0 >> 6, j = t0 & 63;
        v2u v[8];
#pragma unroll
        for (int w = 0; w < 8; ++w) v[w] = *(const LAS v2u*)(F.lds + RING_OFF + w * 16384 + (I * 72 + j) * 2);
#pragma unroll
        for (int e = 0; e < 4; ++e) {
            unsigned hv[8];
#pragma unroll
            for (int w = 0; w < 8; ++w) { const unsigned word = (e < 2) ? v[w].x : v[w].y; hv[w] = (e & 1) ? (word >> 16) : (word & 0xffffu); }
            v4u o; o.x = hv[0] | (hv[1] << 16); o.y = hv[2] | (hv[3] << 16); o.z = hv[4] | (hv[5] << 16); o.w = hv[6] | (hv[7] << 16);
            *(GAS v4u*)(MIX + (size_t)(rowbase + t0 + e) * DM + 1024 + c0) = o;
        }
    }
}
__device__ __forceinline__ void hyena_phase(const Args& a, Frame& F, int ei) {
    LAS unsigned char* slab = F.lds + RING_OFF + F.wave * 16384;
    for (int it = F.gw; it < 4096; it += F.NGW) {
        const int c = it & 1023, rg = it < 2048 ? 2 + (it >> 10) : ((it - 2048) >> 10);
        hyena_mfma_item(a, ei, rg, c, slab, F.lane);
        __syncthreads();
        hyena_store_block(a, F, rg * 4096, c & ~7);
        __syncthreads();
    }
}
__device__ __forceinline__ void rg_gates(const Args& a, Frame& F, int oi) {
    const bf16* P = (const bf16*)(a.ws + WS_PROJ); unsigned* AB = (unsigned*)(a.ws + WS_AB);
    LAS float* xs = (LAS float*)(F.lds + RING_OFF + F.wave * 16384);
    const int r32 = F.lane & 31, hh = F.lane >> 5;
    for (int it = F.gw; it < (T / 64) * RG_NB; it += F.NGW) {
        const int nb = it & 15, tt = it >> 4, row0 = tt * 64, ch = nb * 64 + F.lane;
        const int sq0 = row0 < TP ? 0 : TP, L = row0 < TP ? NP_L : NS_L, tseq0 = (row0 - sq0) & (L - 1);
        {   const float* cw = a.in[I_RGCW] + (size_t)oi * 4 * 1024; const float w0 = cw[ch], w1 = cw[1024 + ch], w2 = cw[2048 + ch], w3 = cw[3072 + ch], cb = a.in[I_RGCB][oi * 1024 + ch];
            const bf16* pc = P + (size_t)row0 * ODD_LD + ch;
            float xm2 = tseq0 >= 2 ? bf2f(pc[-2 * ODD_LD]) : 0.f, xm1 = tseq0 >= 1 ? bf2f(pc[-ODD_LD]) : 0.f, x0 = bf2f(pc[0]);
#pragma unroll 16
            for (int k = 0; k < 64; ++k) { const float xp1 = (tseq0 + k < L - 1) ? bf2f(pc[(size_t)(k + 1) * ODD_LD]) : 0.f;
                xs[k * 64 + F.lane] = cb + w0 * xm2 + w1 * xm1 + w2 * x0 + w3 * xp1; xm2 = xm1; xm1 = x0; x0 = xp1; } }
        asm volatile("s_waitcnt lgkmcnt(0)" ::: "memory");
        bf16x8 af[2][4];
#pragma unroll
        for (int mt = 0; mt < 2; ++mt)
#pragma unroll
            for (int ks = 0; ks < 4; ++ks) { const LAS float* s = xs + (32 * mt + r32) * 64 + 16 * ks + 8 * hh; const f32x4 x0 = *(const LAS f32x4*)s, x1 = *(const LAS f32x4*)(s + 4);
                v4u w; w.x = pk2(x0.x, x0.y); w.y = pk2(x0.z, x0.w); w.z = pk2(x1.x, x1.y); w.w = pk2(x1.z, x1.w); af[mt][ks] = __builtin_bit_cast(bf16x8, w); }
#pragma unroll 1
        for (int d = 0; d < 2; ++d) {
#pragma unroll 1
            for (int nt = 0; nt < 2; ++nt) {
                const int dout = 32 * nt + r32, co = nb * 64 + dout;
                const GAS bf16x8* wf = (const GAS bf16x8*)(a.ws + WS_WGF) + ((size_t)((((oi * 2 + d) * 2 + 0) * RG_NB + nb) * 2 + nt)) * 256 + F.lane;
                bf16x8 ba[4], bi[4];
#pragma unroll
                for (int ks = 0; ks < 4; ++ks) { ba[ks] = wf[ks * 64]; bi[ks] = wf[RG_NB * 2 * 256 + ks * 64]; }
                const float bav = a.in[I_RGBA][(oi * 2 + d) * 1024 + co], biv = a.in[I_RGBI][(oi * 2 + d) * 1024 + co];
                const float lam = a.in[I_RGLAM][(oi * 2 + d) * 1024 + co], sp = log1pf(expf(-lam));
#pragma unroll
                for (int mt = 0; mt < 2; ++mt) {
                    f32x16 ar, ai;
#pragma unroll
                    for (int e = 0; e < 16; ++e) { ar[e] = 0.f; ai[e] = 0.f; }
#pragma unroll
                    for (int ks = 0; ks < 4; ++ks) { ar = __builtin_amdgcn_mfma_f32_32x32x16_bf16(af[mt][ks], ba[ks], ar, 0, 0, 0); ai = __builtin_amdgcn_mfma_f32_32x32x16_bf16(af[mt][ks], bi[ks], ai, 0, 0, 0); }
#pragma unroll
                    for (int e = 0; e < 16; ++e) { const int tk = 32 * mt + (e & 3) + 8 * (e >> 2) + 4 * hh;
                        const float r = sigmoidf_(ar[e] + bav), ig = sigmoidf_(ai[e] + biv);
                        const float loga = -8.0f * r * sp, am = 1.0f - __expf(loga), bv = __builtin_amdgcn_sqrtf(am * (2.0f - am)) * (ig * xs[tk * 64 + dout]);
                        AB[((size_t)(row0 + tk) * 2 + d) * 1024 + co] = pk2(am, bv); }
                }
            }
        }
        asm volatile("s_waitcnt lgkmcnt(0)" ::: "memory");
        asm volatile("s_waitcnt vmcnt(0)" ::: "memory");
        {   float* RGS = (float*)(a.ws + WS_RGS);
#pragma unroll
            for (int d = 0; d < 2; ++d) { float A = 1.f, h = 0.f;
#pragma unroll 16
                for (int k = 0; k < 64; ++k) { const int row = row0 + (d == 0 ? k : 63 - k); const unsigned w = __builtin_nontemporal_load(AB + ((size_t)row * 2 + d) * 1024 + ch);
                    const float av = 1.0f - __uint_as_float(w << 16), bv = __uint_as_float(w & 0xffff0000u); A *= av; h = av * h + bv; }
                float* o = RGS + ((size_t)(tt * 2 + d) * 2) * 1024 + ch; o[0] = A; o[1024] = h; }
        }
    }
}
__device__ __forceinline__ void rg_pass2(const Args& a, Frame& F, int oi) {
    const bf16* P = (const bf16*)(a.ws + WS_PROJ); const unsigned* AB = (const unsigned*)(a.ws + WS_AB); const float* RGS = (const float*)(a.ws + WS_RGS);
    bf16* MIX = (bf16*)(a.ws + WS_MIX);
    LAS float* hf = (LAS float*)(F.lds + RING_OFF + F.wave * 16384);
    for (int it = F.gw; it < 256 * RG_NB; it += F.NGW) {
        const int nb = it & 15, ck = it >> 4, ch = nb * 64 + F.lane, row0 = ck * 64;
        int cfirst, clast, sb = -1, pb = -1;
        if (ck < 128) { pb = ck >> 2; cfirst = pb * 4; clast = cfirst + 3; } else { sb = (ck - 128) >> 6; cfirst = 128 + sb * 64; clast = cfirst + 63; }
        float h = (sb >= 0) ? a.in[I_SRG][((size_t)(sb * 2 + oi) * 2 + 0) * 1024 + ch] : 0.f;
        for (int c0 = cfirst; c0 < ck; c0 += 16) {
            float fa[16], fb[16];
#pragma unroll
            for (int q = 0; q < 16; ++q) { const int c = c0 + q; const bool ok = c < ck; const float* s = RGS + ((size_t)((ok ? c : cfirst) * 2 + 0) * 2) * 1024 + ch; fa[q] = ok ? s[0] : 1.f; fb[q] = ok ? s[1024] : 0.f; }
#pragma unroll
            for (int q = 0; q < 16; ++q) h = fa[q] * h + fb[q]; }
#pragma unroll 16
        for (int k = 0; k < 64; ++k) { const unsigned w = AB[((size_t)(row0 + k) * 2 + 0) * 1024 + ch]; h = (1.0f - __uint_as_float(w << 16)) * h + __uint_as_float(w & 0xffff0000u); hf[k * 64 + F.lane] = h; }
        if (pb >= 0 && ck == clast) a.out[OUT_RG + ((size_t)(pb * 2 + oi) * 2 + 0) * 1024 + ch] = h;
        h = (sb >= 0) ? a.in[I_SRG][((size_t)(sb * 2 + oi) * 2 + 1) * 1024 + ch] : 0.f;
        for (int c0 = clast; c0 > ck; c0 -= 16) {
            float fa[16], fb[16];
#pragma unroll
            for (int q = 0; q < 16; ++q) { const int c = c0 - q; const bool ok = c > ck; const float* s = RGS + ((size_t)((ok ? c : clast) * 2 + 1) * 2) * 1024 + ch; fa[q] = ok ? s[0] : 1.f; fb[q] = ok ? s[1024] : 0.f; }
#pragma unroll
            for (int q = 0; q < 16; ++q) h = fa[q] * h + fb[q]; }
#pragma unroll 16
        for (int k = 63; k >= 0; --k) { const size_t row = (size_t)(row0 + k); const unsigned w = AB[(row * 2 + 1) * 1024 + ch]; h = (1.0f - __uint_as_float(w << 16)) * h + __uint_as_float(w & 0xffff0000u);
            const float y = (hf[k * 64 + F.lane] + h) * gelu_tanh(bf2f(P[row * ODD_LD + 1024 + ch]));
            MIX[row * DM + ch] = (bf16)f2bf(y); }
        if (pb >= 0 && ck == cfirst) a.out[OUT_RG + ((size_t)(pb * 2 + oi) * 2 + 1) * 1024 + ch] = h;
        LDS_WAIT(); asm volatile("" ::: "memory");
    }
}

constexpr float QSCALE = 0.125f * 1.4426950408889634f, LOG2E = 1.4426950408889634f;
__device__ __forceinline__ void qk_norm(const Args& a, Frame& F, int oi) {
    const bf16* P = (const bf16*)(a.ws + WS_PROJ); bf16* Qb = (bf16*)(a.ws + WS_QN); bf16* Kb = (bf16*)(a.ws + WS_KN);
    const int dl = (F.lane & 15) * 4;
    const f32x4 gq = *(const GAS f32x4*)(a.in[I_NAQN] + oi * 64 + dl) * QSCALE, gk = *(const GAS f32x4*)(a.in[I_NAKN] + oi * 64 + dl);
    for (int row = F.gw; row < T; row += F.NGW) {
        const bf16* p = P + (size_t)row * ODD_LD;
#pragma unroll
        for (int ps = 0; ps < 4; ++ps) {
            const int col = ps * 256 + F.lane * 4;
            const v2u qw = *(const GAS v2u*)(p + 2048 + col), kw = *(const GAS v2u*)(p + 3072 + col);
            const f32x4 q = {__uint_as_float(qw.x << 16), __uint_as_float(qw.x & 0xffff0000u), __uint_as_float(qw.y << 16), __uint_as_float(qw.y & 0xffff0000u)};
            const f32x4 k = {__uint_as_float(kw.x << 16), __uint_as_float(kw.x & 0xffff0000u), __uint_as_float(kw.y << 16), __uint_as_float(kw.y & 0xffff0000u)};
            float sq = (q.x * q.x + q.y * q.y) + (q.z * q.z + q.w * q.w), sk = (k.x * k.x + k.y * k.y) + (k.z * k.z + k.w * k.w);
            sq += __shfl_xor(sq, 1); sk += __shfl_xor(sk, 1); sq += __shfl_xor(sq, 2); sk += __shfl_xor(sk, 2); sq += __shfl_xor(sq, 4); sk += __shfl_xor(sk, 4); sq += __shfl_xor(sq, 8); sk += __shfl_xor(sk, 8);
            const float rq = 1.0f / sqrtf(sq * (1.0f / 64.0f) + EPS), rk = 1.0f / sqrtf(sk * (1.0f / 64.0f) + EPS);
            const f32x4 qn = q * rq * gq, kn = k * rk * gk;
            v2u wq, wk; wq.x = pk2(qn.x, qn.y); wq.y = pk2(qn.z, qn.w); wk.x = pk2(kn.x, kn.y); wk.y = pk2(kn.z, kn.w);
            *(GAS v2u*)(Qb + (size_t)row * 1024 + col) = wq; *(GAS v2u*)(Kb + (size_t)row * 1024 + col) = wk;
            if (row < TP) { const int b = row >> 8, tk = row & 255; const size_t o = ((size_t)((b * 2 + oi) * NP_L + tk)) * 1024 + col;
                *(GAS f32x4*)(a.out + OUT_NAK + o) = kn; }
        }
    }
}
__device__ __forceinline__ void na_v_out(const Args& a, Frame& F, int oi) {
    const bf16* VT = (const bf16*)(a.ws + WS_VT);
    LAS unsigned short* s = (LAS unsigned short*)(F.lds + RING_OFF + F.wave * 16384);
    for (int it = F.gw; it < 16 * (TP / 64); it += F.NGW) {
        const int ct = it & 15, tt = it >> 4, c0 = ct * 64, t0 = tt * 64;
#pragma unroll 8
        for (int i = 0; i < 64; ++i) s[i * 66 + F.lane] = VT[(size_t)(c0 + i) * T + t0 + F.lane];
        asm volatile("s_waitcnt lgkmcnt(0)" ::: "memory");
#pragma unroll 8
        for (int tl = 0; tl < 64; ++tl) { const int row = t0 + tl, b = row >> 8, tk = row & 255;
            a.out[OUT_NAV + ((size_t)((b * 2 + oi) * NP_L + tk)) * 1024 + c0 + F.lane] = bf2f(s[F.lane * 66 + tl]); }
        asm volatile("s_waitcnt lgkmcnt(0)" ::: "memory");
    }
}
struct AttnState { f32x16 o[2]; float m, l; };
__device__ __forceinline__ void attn_reset(AttnState& S) { S.m = -1e30f; S.l = 0.f;
#pragma unroll
    for (int e = 0; e < 16; ++e) { S.o[0][e] = 0.f; S.o[1][e] = 0.f; } }
__device__ __forceinline__ f32x16 attn_scores(const bf16x8 (&kf)[4], const bf16x8 (&qf)[4]) {
    f32x16 st;
#pragma unroll
    for (int e = 0; e < 16; ++e) st[e] = 0.f;
#pragma unroll
    for (int ks = 0; ks < 4; ++ks) st = __builtin_amdgcn_mfma_f32_32x32x16_bf16(kf[ks], qf[ks], st, 0, 0, 0);
    return st;
}
__device__ __forceinline__ void attn_update(AttnState& S, const f32x16& st, const bf16x8 (&vf)[2][2]) {
    float mx = st[0];
#pragma unroll
    for (int e = 1; e < 16; ++e) mx = fmaxf(mx, st[e]);
    mx = fmaxf(mx, __shfl_xor(mx, 32));
    const float mn = fmaxf(S.m, mx), alpha = __builtin_amdgcn_exp2f(S.m - mn);
    S.m = mn;
    float p[16], ps = 0.f;
#pragma unroll
    for (int e = 0; e < 16; ++e) { p[e] = __builtin_amdgcn_exp2f(st[e] - mn); ps += p[e]; }
    S.l = S.l * alpha + ps;
#pragma unroll
    for (int e = 0; e < 16; ++e) { S.o[0][e] *= alpha; S.o[1][e] *= alpha; }
#pragma unroll
    for (int s = 0; s < 2; ++s) {
        v4u w; w.x = pg8::cvt_pk_bf16(p[8 * s], p[8 * s + 1]); w.y = pg8::cvt_pk_bf16(p[8 * s + 2], p[8 * s + 3]); w.z = pg8::cvt_pk_bf16(p[8 * s + 4], p[8 * s + 5]); w.w = pg8::cvt_pk_bf16(p[8 * s + 6], p[8 * s + 7]);
        const bf16x8 pb = __builtin_bit_cast(bf16x8, w);
        S.o[0] = __builtin_amdgcn_mfma_f32_32x32x16_bf16(vf[0][s], pb, S.o[0], 0, 0, 0);
        S.o[1] = __builtin_amdgcn_mfma_f32_32x32x16_bf16(vf[1][s], pb, S.o[1], 0, 0, 0);
    }
}
__device__ __forceinline__ bf16x8 join8(v2u lo, v2u hi) { v4u w; w.x = lo.x; w.y = lo.y; w.z = hi.x; w.w = hi.y; return __builtin_bit_cast(bf16x8, w); }
constexpr int AK_STR = 144, AV_STR = 520, AK_BYTES = 256 * AK_STR, AV_BYTES = 64 * AV_STR, ABIAS_OFF = AK_BYTES + AV_BYTES;
__device__ __forceinline__ void attn_stage_chunk(LAS unsigned char* lds, const bf16* kg, int ldk, const bf16* vg, int ldv, int tid) {
#pragma unroll
    for (int ps = 0; ps < 4; ++ps) { const int i = tid + ps * NTHR, key = i >> 3, seg = i & 7;
        *(LAS v4u*)(lds + key * AK_STR + seg * 16) = *(const GAS v4u*)(kg + (size_t)key * ldk + seg * 8); }
#pragma unroll
    for (int ps = 0; ps < 4; ++ps) { const int i = tid + ps * NTHR, d = i >> 5, seg = i & 31;
        const v4u v = *(const GAS v4u*)(vg + (size_t)d * ldv + seg * 8);
        LAS v2u* dst = (LAS v2u*)(lds + AK_BYTES + d * AV_STR + seg * 16); dst[0] = (v2u){v.x, v.y}; dst[1] = (v2u){v.z, v.w}; }
}
__device__ __forceinline__ void attn_chunk(AttnState& S, const bf16x8 (&qf)[4], const LAS unsigned char* lds, int lane) {
    const int r = lane & 31, h = lane >> 5;
#pragma unroll 2
    for (int kt = 0; kt < 8; ++kt) {
        bf16x8 kf[4];
        const LAS unsigned char* kp = lds + (kt * 32 + r) * AK_STR + 16 * h;
#pragma unroll
        for (int ks = 0; ks < 4; ++ks) kf[ks] = *(const LAS bf16x8*)(kp + 32 * ks);
        bf16x8 vf[2][2];
#pragma unroll
        for (int mt = 0; mt < 2; ++mt)
#pragma unroll
            for (int s = 0; s < 2; ++s) { const LAS unsigned char* vp = lds + AK_BYTES + (32 * mt + r) * AV_STR + (kt * 32 + 16 * s + 4 * h) * 2;
                vf[mt][s] = join8(*(const LAS v2u*)vp, *(const LAS v2u*)(vp + 16)); }
        const f32x16 st = attn_scores(kf, qf);
        attn_update(S, st, vf);
    }
}
__device__ __forceinline__ void attn_load_q(bf16x8 (&qf)[4], const bf16* qrow0  , int lane) {
    const bf16* qp = qrow0 + (size_t)(lane & 31) * 1024 + 8 * (lane >> 5);
#pragma unroll
    for (int ks = 0; ks < 4; ++ks) qf[ks] = *(const GAS bf16x8*)(qp + 16 * ks);
}
__device__ __forceinline__ void attn_store(AttnState& S, bf16* orow0  , int lane) {
    const float lt = S.l + __shfl_xor(S.l, 32), il = 1.0f / lt;
    bf16* op = orow0 + (size_t)(lane & 31) * DM + 4 * (lane >> 5);
#pragma unroll
    for (int mt = 0; mt < 2; ++mt)
#pragma unroll
        for (int g = 0; g < 4; ++g) { v2u w; w.x = pk2(S.o[mt][4 * g] * il, S.o[mt][4 * g + 1] * il); w.y = pk2(S.o[mt][4 * g + 2] * il, S.o[mt][4 * g + 3] * il);
            *(GAS v2u*)(op + 32 * mt + 8 * g) = w; }
}
__device__ __forceinline__ void attn_ctx(const Args& a, Frame& F) {
    const bf16* Qb = (const bf16*)(a.ws + WS_QN); const bf16* Kb = (const bf16*)(a.ws + WS_KN); const bf16* VT = (const bf16*)(a.ws + WS_VT);
    bf16* MIX = (bf16*)(a.ws + WS_MIX);
    LAS unsigned char* lds = F.lds + RING_OFF;
    for (int it = F.vcu; it < NP_B * NA_H; it += F.G) {
        const int b = it >> 4, hd = it & 15, row0 = b * NP_L;
        __syncthreads();
        attn_stage_chunk(lds, Kb + (size_t)row0 * 1024 + hd * 64, 1024, VT + (size_t)(hd * 64) * T + row0, T, F.tid);
        bf16x8 qf[4]; attn_load_q(qf, Qb + (size_t)(row0 + F.wave * 32) * 1024 + hd * 64, F.lane);
        AttnState S; attn_reset(S);
        __syncthreads();
        attn_chunk(S, qf, lds, F.lane);
        attn_store(S, MIX + (size_t)(row0 + F.wave * 32) * DM + 1024 + hd * 64, F.lane);
    }
    __syncthreads();
}
__device__ __forceinline__ void attn_na(const Args& a, Frame& F, int oi) {
    const bf16* Qb = (const bf16*)(a.ws + WS_QN); const bf16* Kb = (const bf16*)(a.ws + WS_KN); const bf16* VT = (const bf16*)(a.ws + WS_VT);
    const bf16* CKB = (const bf16*)(a.ws + WS_CKB); const bf16* CVT = (const bf16*)(a.ws + WS_CVT);
    bf16* MIX = (bf16*)(a.ws + WS_MIX);
    LAS unsigned char* lds = F.lds + RING_OFF;
    LAS float* bias = (LAS float*)(lds + 126976);
    constexpr int LV_STR = 1416;
    const int r32 = F.lane & 31, h = F.lane >> 5;
    for (int it = F.vcu; it < NS_B * NA_H * 16; it += F.G) {
        const int rg = it & 15, hd = (it >> 4) & 15, b = it >> 8;
        const int gr = rg * 4 + (F.wave >> 1), c0 = 32 * (F.wave & 1), qrow0 = TP + b * NS_L + gr * GRID_W + c0;
        bf16x8 qf[4]; attn_load_q(qf, Qb + (size_t)qrow0 * 1024 + hd * 64, F.lane);
        AttnState S; attn_reset(S);
        const size_t cbase = (size_t)(b * 2 + oi);
        for (int ck = 0; ck < 2; ++ck) {
            __syncthreads();
            attn_stage_chunk(lds, CKB + (cbase * PAST + ck * 256) * 1024 + hd * 64, 1024, CVT + (cbase * 1024 + hd * 64) * PAST + ck * 256, PAST, F.tid);
            if (ck == 0) { const float* rpb = a.in[I_NARPB] + (size_t)(oi * NA_H + hd) * 15 * 31; for (int i = F.tid; i < 15 * 31; i += NTHR) bias[i] = rpb[i] * LOG2E; }
            __syncthreads();
            attn_chunk(S, qf, lds, F.lane);
        }
        const int qc = c0 + r32, rs = min(max(gr - WIN_R / 2, 0), GRID_R - WIN_R), cs = min(max(qc - WIN_C / 2, 0), GRID_W - WIN_C);
        const size_t tbase = (size_t)(TP + b * NS_L + rs * GRID_W);
        const bf16* kbase = Kb + (tbase + r32) * 1024 + hd * 64 + 8 * h;
        const int R0 = min(max(rg * 4 - WIN_R / 2, 0), GRID_R - WIN_R), R1 = min(max(rg * 4 + 3 - WIN_R / 2, 0), GRID_R - WIN_R) + WIN_R, NK16 = (R1 - R0) * 8;
        __syncthreads();
        {   const bf16* vsrc = VT + (size_t)(hd * 64) * T + (size_t)(TP + b * NS_L + R0 * GRID_W);
            for (int i = F.tid; i < 64 * NK16; i += NTHR) { const int d = i / NK16, pc = i - d * NK16; const v4u v = *(const GAS v4u*)(vsrc + (size_t)d * T + pc * 8);
                LAS v2u* dst = (LAS v2u*)(lds + d * LV_STR + pc * 16); dst[0] = (v2u){v.x, v.y}; dst[1] = (v2u){v.z, v.w}; } }
        __syncthreads();
        const LAS unsigned char* vloc = lds + r32 * LV_STR + ((rs - R0) * GRID_W + 4 * h) * 2;
#define NA_LOAD(ti_, kf_, vf_) do { const int to_ = ((ti_) >> 1) * GRID_W + ((ti_) & 1) * 32; \
            _Pragma("unroll") for (int ks = 0; ks < 4; ++ks) kf_[ks] = *(const GAS bf16x8*)(kbase + (size_t)to_ * 1024 + 16 * ks); \
            _Pragma("unroll") for (int mt = 0; mt < 2; ++mt) _Pragma("unroll") for (int s = 0; s < 2; ++s) { const LAS unsigned char* vp_ = vloc + (32 * mt) * LV_STR + (to_ + 16 * s) * 2; \
                vf_[mt][s] = join8(*(const LAS v2u*)vp_, *(const LAS v2u*)(vp_ + 16)); } } while (0)
#define NA_PROC(ti_, kf_, vf_) do { const int krow_ = rs + ((ti_) >> 1), ct_ = (ti_) & 1; \
            const LAS float* brow_ = bias + (krow_ - gr + WIN_R - 1) * 31 + (WIN_C - 1) - qc; \
            f32x16 st_ = attn_scores(kf_, qf); \
            _Pragma("unroll") for (int e = 0; e < 16; ++e) { const int kc_ = 32 * ct_ + (e & 3) + 8 * (e >> 2) + 4 * h; \
                st_[e] = ((unsigned)(kc_ - cs) < (unsigned)WIN_C) ? st_[e] + brow_[kc_] : -1e30f; } \
            attn_update(S, st_, vf_); } while (0)
        {   bf16x8 kA[4], kB[4], vA[2][2], vB[2][2];
            NA_LOAD(0, kA, vA);
#pragma unroll 1
            for (int tp = 0; tp < 16; tp += 2) {
                NA_LOAD(tp + 1, kB, vB);
                NA_PROC(tp, kA, vA);
                if (tp + 2 < 16) NA_LOAD(tp + 2, kA, vA);
                NA_PROC(tp + 1, kB, vB);
            }
        }
#undef NA_LOAD
#undef NA_PROC
        attn_store(S, MIX + (size_t)qrow0 * DM + 1024 + hd * 64, F.lane);
    }
    __syncthreads();
}
#ifndef EN
#define EN 0xFFFF
#endif
#ifndef EN_GEMM
#define EN_GEMM 63
#endif
constexpr int NPHASES = 2 + 2 * 12 + 2 * 11;
typedef const __attribute__((address_space(4))) Args* KArgsPtr;
__device__ __forceinline__ Frame mkframe(unsigned char* lds_raw) {
    Frame F;
    int tid = threadIdx.x, bx = blockIdx.x, G = gridDim.x;
    asm volatile("" : "+v"(tid), "+s"(bx), "+s"(G));
    F.lds = (LAS unsigned char*)lds_raw;
    F.tid = tid; F.lane = tid & 63; F.wave = __builtin_amdgcn_readfirstlane(tid >> 6);
    F.G = G; F.vcu = (G % 8 == 0) ? (bx % 8) * (G / 8) + bx / 8 : bx;
    F.gw = F.vcu * NWAVES + F.wave; F.NGW = G * NWAVES;
    return F;
}
__global__ void __launch_bounds__(NTHR, 2) fwd_kernel(Args args_unused) {
    extern __shared__ __attribute__((aligned(16))) unsigned char lds_raw[];
    {   LAS unsigned* z = (LAS unsigned*)((LAS unsigned char*)lds_raw + LDSCTL_OFF);
        for (int u = threadIdx.x; u < (LDS_BYTES - LDSCTL_OFF) / 4; u += NTHR) z[u] = 0u; }
    __syncthreads();
    KArgsPtr kp0 = (KArgsPtr)__builtin_amdgcn_kernarg_segment_ptr();
    XcdBarrier bar = xcd_barrier_post((unsigned*)(kp0->ws + WS_CTL) + CW_BAR, (volatile LAS unsigned*)((LAS unsigned char*)lds_raw + MISC_OFF) + 8);
    const int lo = kp0->ph_lo, hi = kp0->ph_hi;
    int pc = 0;
#define PH_ON() (pc >= lo && pc < hi)
#ifndef REPEAT_MASK
#define REPEAT_MASK 0
#endif
#ifndef PROBE_MASK
#define PROBE_MASK 0
#endif
#if PROBE_MASK
    unsigned long long pr_prev = __builtin_amdgcn_s_memrealtime();
    LAS unsigned* pr_acc = (LAS unsigned*)((LAS unsigned char*)lds_raw + LDSCTL_OFF + 1024);
#define PH_END(cls) do { if (pc >= lo && pc + 1 < hi) xcd_barrier(bar); ++pc; \
        if (blockIdx.x == 0 && threadIdx.x == 0) { const unsigned long long t_ = __builtin_amdgcn_s_memrealtime(); pr_acc[cls] += (unsigned)(t_ - pr_prev); pr_prev = t_; } } while (0)
#else
#define PH_END(cls) do { if (pc >= lo && pc + 1 < hi) xcd_barrier(bar); ++pc; } while (0)
#endif
#define PH_ARGS() KArgsPtr kp = (KArgsPtr)__builtin_amdgcn_kernarg_segment_ptr(); asm volatile("" : "+s"(kp)); const Args args = *(const Args*)kp; Frame F = mkframe(lds_raw); \
    unsigned char* ws = args.ws; float* X = args.out; LAS unsigned char* ring = F.lds + RING_OFF; (void)ws; (void)X; (void)ring; (void)F

    if (PH_ON()) { PH_ARGS(); for (int rep_ = 0; rep_ < (((REPEAT_MASK >> 0) & 1) ? 2 : 1); ++rep_) {
        for (int r2 = 0; r2 < (((REPEAT_MASK >> 17) & 1) ? 2 : 1); ++r2) p0_adaln(args, F);
        for (int r2 = 0; r2 < (((REPEAT_MASK >> 18) & 1) ? 2 : 1); ++r2) { p0_s5params(args, F); p0_cache_k(args, F); p0_gate_frags(args, F); }
        for (int r2 = 0; r2 < (((REPEAT_MASK >> 19) & 1) ? 2 : 1); ++r2) p0_hyena_h2(args, F);
        for (int r2 = 0; r2 < (((REPEAT_MASK >> 20) & 1) ? 2 : 1); ++r2) p0_weights(args, F);
    } }
    PH_END(0);
    if (PH_ON()) { PH_ARGS(); for (int rep_ = 0; rep_ < (((REPEAT_MASK >> 1) & 1) ? 2 : 1); ++rep_) { p0b_adaln_final(args, F); p0b_hyena_filters(args, F); } }
    PH_END(1);

#pragma clang loop unroll(disable)
#ifndef NLAYERS
#define NLAYERS DEPTH
#endif
    for (int li = 0; li < NLAYERS; ++li) {
#pragma clang loop unroll(disable)
        for (int half = 0; half < 2; ++half) {
#define MODP() ((const float*)(ws + WS_MOD) + (size_t)li * 3 * NMOD * DM)
#define NGP() (args.in[I_NG] + (size_t)li * 3 * DM)
            if (PH_ON()) { PH_ARGS(); for (int rep_ = 0; rep_ < (((REPEAT_MASK >> 2) & 1) ? 2 : 1); ++rep_) { phase_norm(args, F, NGP() + (half ? 2 : 0) * DM, MODP() + (half ? 6 : 0) * DM, MODP() + (half ? 7 : 1) * DM, li == 0 && half == 0); } }
            PH_END(2);
            if (PH_ON()) { PH_ARGS(); for (int rep_ = 0; rep_ < (((REPEAT_MASK >> 3) & 1) ? 2 : 1); ++rep_) { pg8::Gemm g{(const bf16*)(ws + WS_H), (const bf16*)(ws + WS_WGU) + (size_t)(li * 2 + half) * 2 * DFF * DM, T, 2 * DFF, DM};
                pg8::StaticOrder S; S.init(T, 2 * DFF, F.G, (int)blockIdx.x); pg8::EpiSwiGLU E{(bf16*)(ws + WS_A1), DFF};
                if (EN_GEMM & 1) pg8::gemm_phase<pg8::EpiSwiGLU, pg8::StaticOrder, PG8_ALIGN, PG8_SP2>(ring, g, S, E); } }
            PH_END(3);
            if (PH_ON()) { PH_ARGS(); for (int rep_ = 0; rep_ < (((REPEAT_MASK >> 4) & 1) ? 2 : 1); ++rep_) { pg8::Gemm g{(const bf16*)(ws + WS_A1), (const bf16*)(ws + WS_WD) + (size_t)(li * 2 + half) * DM * DFF, T, DM, DFF};
                pg8::StaticOrder S; S.init(T, DM, F.G, (int)blockIdx.x);
                if (li == NLAYERS - 1 && half == 1) { pg8::EpiFinal E{(const bf16*)(ws + WS_XB), X, DM, MODP() + (half ? 8 : 2) * DM, NMOD * DM, 0.5f};
                    pg8::gemm_phase<pg8::EpiFinal, pg8::StaticOrder, PG8_ALIGN, PG8_SP2>(ring, g, S, E); }
                else { pg8::EpiXb E{(bf16*)(ws + WS_XB), DM, MODP() + (half ? 8 : 2) * DM, NMOD * DM, 0.5f};
                    pg8::gemm_phase<pg8::EpiXb, pg8::StaticOrder, PG8_ALIGN, PG8_SP2>(ring, g, S, E); } } }
            PH_END(4);
            if (half == 0) {
                if (PH_ON()) { PH_ARGS(); for (int rep_ = 0; rep_ < (((REPEAT_MASK >> 2) & 1) ? 2 : 1); ++rep_) { if (li == 0) p0b_hyena_norm(args, F); phase_norm(args, F, NGP() + DM, MODP() + 3 * DM, MODP() + 4 * DM, false); } }
                PH_END(2);
                if ((li & 1) == 0) {
                    const int ei = li >> 1;
                    if (PH_ON()) { PH_ARGS(); for (int rep_ = 0; rep_ < (((REPEAT_MASK >> 5) & 1) ? 2 : 1); ++rep_) {
                        { pg8::Gemm g{(const bf16*)(ws + WS_H), (const bf16*)(ws + WS_WINE) + (size_t)ei * EVEN_IN * DM, T, HALFW, DM};
                          pg8::StaticOrder S; S.init(T, HALFW, F.G, (int)blockIdx.x); pg8::EpiBf16 E{(bf16*)(ws + WS_PROJ), HALFW};
                          if (EN_GEMM & 4) pg8::gemm_phase<pg8::EpiBf16, pg8::StaticOrder, PG8_ALIGN, PG8_SP2>(ring, g, S, E); }
                        { pg8::Gemm g{(const bf16*)(ws + WS_WINE) + (size_t)ei * EVEN_IN * DM + (size_t)HALFW * DM, (const bf16*)(ws + WS_H), 3 * HALFW, T, DM};
                          pg8::StaticOrder S; S.init(3 * HALFW, T, F.G, (int)blockIdx.x); pg8::EpiBf16 E{(bf16*)(ws + WS_PROJ + PROJT_OFF), T};
                          if (EN_GEMM & 4) pg8::gemm_phase<pg8::EpiBf16, pg8::StaticOrder, PG8_ALIGN, PG8_SP2>(ring, g, S, E); }
                    } }
                    PH_END(5);
                    if (PH_ON()) { PH_ARGS(); for (int rep_ = 0; rep_ < (((REPEAT_MASK >> 6) & 1) ? 2 : 1); ++rep_) {
#if EN & 8
                        s5_pass1(args, F, ei); __syncthreads();
#endif
#if EN & 16
                        hyena_phase(args, F, ei);
#endif
                    } }
                    PH_END(6);
                    if (PH_ON()) { PH_ARGS(); for (int rep_ = 0; rep_ < (((REPEAT_MASK >> 7) & 1) ? 2 : 1); ++rep_) {
#if EN & 32
                        s5_pass2(args, F, ei); __syncthreads();
#endif
                    } }
                    PH_END(7);
                    if (PH_ON()) { PH_ARGS(); for (int rep_ = 0; rep_ < (((REPEAT_MASK >> 8) & 1) ? 2 : 1); ++rep_) { pg8::Gemm g{(const bf16*)(ws + WS_Z), (const bf16*)(ws + WS_WGLU) + (size_t)ei * HALFW * HALFW, T, HALFW, HALFW};
                        pg8::StaticOrder S; S.init(T, HALFW, F.G, (int)blockIdx.x); pg8::EpiGLU E{(const bf16*)(ws + WS_Z), HALFW, args.in[I_S5GLUB] + ei * HALFW, (bf16*)(ws + WS_MIX), DM};
                        if (EN_GEMM & 8) pg8::gemm_phase<pg8::EpiGLU, pg8::StaticOrder, PG8_ALIGN, PG8_SP2>(ring, g, S, E); } }
                    PH_END(8);
                } else {
                    const int oi = li >> 1;
                    if (PH_ON()) { PH_ARGS(); for (int rep_ = 0; rep_ < (((REPEAT_MASK >> 9) & 1) ? 2 : 1); ++rep_) { pg8::Gemm g{(const bf16*)(ws + WS_H), (const bf16*)(ws + WS_WINO) + (size_t)oi * ODD_IN * DM, T, ODD_LD, DM};
                        pg8::StaticOrder S; S.init(T, ODD_LD, F.G, (int)blockIdx.x); pg8::EpiBf16 E{(bf16*)(ws + WS_PROJ), ODD_LD};
                        if (EN_GEMM & 16) pg8::gemm_phase<pg8::EpiBf16, pg8::StaticOrder, PG8_ALIGN, PG8_SP2>(ring, g, S, E); }
                      { pg8::Gemm g{(const bf16*)(ws + WS_WINO) + (size_t)oi * ODD_IN * DM + (size_t)4096 * DM, (const bf16*)(ws + WS_H), HALFW, T, DM};
                        pg8::StaticOrder S; S.init(HALFW, T, F.G, (int)blockIdx.x); pg8::EpiBf16 E{(bf16*)(ws + WS_VT), T};
                        pg8::gemm_phase<pg8::EpiBf16, pg8::StaticOrder, PG8_ALIGN, PG8_SP2>(ring, g, S, E); } }
                    PH_END(9);
                    if (PH_ON()) { PH_ARGS(); for (int rep_ = 0; rep_ < (((REPEAT_MASK >> 10) & 1) ? 2 : 1); ++rep_) {
#ifdef SKIP_GATES3
                        if (li != 3)
#endif
                        { rg_gates(args, F, oi); __syncthreads(); }
                        qk_norm(args, F, oi); __syncthreads(); na_v_out(args, F, oi);
                    } }
                    PH_END(10);
                    if (PH_ON()) { PH_ARGS(); for (int rep_ = 0; rep_ < (((REPEAT_MASK >> 11) & 1) ? 2 : 1); ++rep_) {
#ifdef SKIP_RG3
                        if (li != 3)
#endif
                        { rg_pass2(args, F, oi); __syncthreads(); }
#ifdef SKIP_ATT3
                        if (li != 3) {
#endif
#ifndef SKIP_CTX
                        attn_ctx(args, F);
#endif
#ifndef SKIP_NA
                        attn_na(args, F, oi);
#endif
#ifdef SKIP_ATT3
                        }
#endif
                    } }
                    PH_END(11);
                }
                if (PH_ON()) { PH_ARGS(); for (int rep_ = 0; rep_ < (((REPEAT_MASK >> 13) & 1) ? 2 : 1); ++rep_) { pg8::Gemm g{(const bf16*)(ws + WS_MIX), (const bf16*)(ws + WS_WOUT) + (size_t)li * DM * DM, T, DM, DM};
                    pg8::StaticOrder S; S.init(T, DM, F.G, (int)blockIdx.x); pg8::EpiXb E{(bf16*)(ws + WS_XB), DM, MODP() + 5 * DM, NMOD * DM, 1.0f};
                    if (EN_GEMM & 32) pg8::gemm_phase<pg8::EpiXb, pg8::StaticOrder, PG8_ALIGN, PG8_SP2>(ring, g, S, E); } }
                PH_END(13);
            }
        }
    }
#if PROBE_MASK && defined(PROBE_SPIN)
    if (blockIdx.x == 0 && threadIdx.x == 0) { unsigned tot = 0; for (int c = 0; c < 16; ++c) if ((PROBE_MASK >> c) & 1) tot += pr_acc[c];
        const unsigned long long t0 = __builtin_amdgcn_s_memrealtime(), wait = (unsigned long long)tot * PROBE_SPIN;
        while (__builtin_amdgcn_s_memrealtime() - t0 < wait) __builtin_amdgcn_s_sleep(32); }
#elif PROBE_MASK
    if (blockIdx.x == 0 && threadIdx.x == 0) { unsigned tot = 0; for (int c = 0; c < 16; ++c) if ((PROBE_MASK >> c) & 1) tot += pr_acc[c];
        KArgsPtr kq = (KArgsPtr)__builtin_amdgcn_kernarg_segment_ptr(); const unsigned us_ = tot / 100u, q_ = ((us_ + 50u) / 100u) * 100u; kq->out[OUT_RG] = (float)q_ * 1000.0f; }
#endif
#undef PH_ON
#undef PH_END
}

extern "C" void kernel_launch(void* const* d_in, const int* in_sizes, int n_in, void* d_out, int out_size, void* d_ws, size_t ws_size, hipStream_t stream) {
    static int grid = 0;
    if (grid == 0) {
        if (n_in != N_IN || (size_t)out_size != OUT_END || ws_size < WS_END) { fprintf(stderr, "kernel_launch: unexpected shapes: n_in %d out %d ws %zu (need %zu)\n", n_in, out_size, ws_size, (size_t)WS_END); grid = -1; return; }
        int dev = 0, cus = 0, per_cu = 0;
        if (hipGetDevice(&dev) != hipSuccess || hipDeviceGetAttribute(&cus, hipDeviceAttributeMultiprocessorCount, dev) != hipSuccess) { grid = -1; return; }
        if (hipFuncSetAttribute((const void*)fwd_kernel, hipFuncAttributeMaxDynamicSharedMemorySize, LDS_BYTES) != hipSuccess) { fprintf(stderr, "kernel_launch: hipFuncSetAttribute failed\n"); grid = -1; return; }
        if (hipOccupancyMaxActiveBlocksPerMultiprocessor(&per_cu, (const void*)fwd_kernel, NTHR, LDS_BYTES) != hipSuccess || per_cu < 1) fprintf(stderr, "kernel_launch: occupancy query says %d\n", per_cu);
        (void)hipGetLastError();
        grid = cus;
    }
    if (grid < 0) return;
    (void)hipMemsetAsync((char*)d_ws + WS_CTL, 0, CTL_ZERO_BYTES, stream);
    Args a{};
    for (int i = 0; i < N_IN; ++i) a.in[i] = (const float*)d_in[i];
    a.out = (float*)d_out; a.ws = (unsigned char*)d_ws;
#if MK_PER_PHASE
    for (int ph = 0; ph < NPHASES; ++ph) { a.ph_lo = ph; a.ph_hi = ph + 1; hipLaunchKernelGGL(fwd_kernel, dim3(grid), dim3(NTHR), LDS_BYTES, stream, a); }
#else
    a.ph_lo = 0; a.ph_hi = NPHASES;
    hipLaunchKernelGGL(fwd_kernel, dim3(grid), dim3(NTHR), LDS_BYTES, stream, a);
#endif
}
```
